# Optimizing an MI355X kernel written in HIP

```python
import math
import numpy as np
import jax
import jax.numpy as jnp
from jax import lax

D_MODEL = 2048
BATCH = 16
SEQ = 2048
DEPTH = 2

GRID_W = 64
CTX_LEN = 256
D_MIX = D_MODEL
GLA_WIDTH = D_MIX // 4
HY_WIDTH = D_MIX // 4
FN_WIDTH = D_MIX // 4
NA_WIDTH = D_MIX - GLA_WIDTH - HY_WIDTH - FN_WIDTH

GLA_HEADS = 4
GLA_DK = GLA_WIDTH // (2 * GLA_HEADS)
GLA_DV = GLA_WIDTH // GLA_HEADS
GLA_GATE_RANK = 16
GLA_TAU = 16.0
GLA_CHUNK = 64

HY_SHORT = 3
HY_BANDS = 16
HY_EMB = 2 * HY_BANDS + 1
HY_FILT_HIDDEN = 64
HY_DECAY_TARGET = 1e-2
HY_FAST_PCT = 0.3
HY_SLOW_PCT = 1.5
HY_DECAY_SHIFT = 0.05

FN_GROUPS = 4
FN_DG = FN_WIDTH // FN_GROUPS

NA_HEADS = 4
NA_DH = NA_WIDTH // NA_HEADS
NA_KR_MAX = 8
NA_KC = 16

ROPE_THETA = 10000.0
D_FF = 5632
FFN_CONV = 3
N_MOD = 6
EPS = 1e-6
F32 = jnp.float32

IN_SPLITS = (GLA_HEADS * GLA_DK, GLA_HEADS * GLA_DK, GLA_WIDTH, GLA_WIDTH, 2 * GLA_GATE_RANK,
             3 * HY_WIDTH, FN_WIDTH, NA_WIDTH, NA_WIDTH, NA_WIDTH)
D_IN = sum(IN_SPLITS)

kernel_name = 'hybrid_parallel_group_diffusion_block'


def rms_norm(x, gain):
    xf = x.astype(F32)
    y = xf * lax.rsqrt(jnp.mean(xf * xf, axis=-1, keepdims=True) + EPS)
    return (y * gain.astype(F32)).astype(x.dtype)


def modulate(h, shift, scale):
    return h * (1 + scale) + shift


def dwconv(u, w, b):
    k_w = w.shape[0]
    left = k_w // 2
    l = u.shape[1]
    up = jnp.pad(u, ((0, 0), (left, k_w - 1 - left), (0, 0)))
    y = b
    for i in range(k_w):
        y = y + up[:, i:i + l] * w[i]
    return y


def to_heads(t, n_heads):
    b, l, _ = t.shape
    return t.reshape(b, l, n_heads, -1).transpose(0, 2, 1, 3)


def from_heads(t):
    b, h, l, d = t.shape
    return t.transpose(0, 2, 1, 3).reshape(b, l, h * d)


def axial_rope(t, rows, cols):
    half = t.shape[-1] // 2
    nf = half // 2
    inv = ROPE_THETA ** (-jnp.arange(nf, dtype=F32) / nf)

    def rotate(u, pos):
        ang = pos.astype(F32)[:, None] * inv
        cos = jnp.cos(ang).astype(u.dtype)
        sin = jnp.sin(ang).astype(u.dtype)
        u1, u2 = u[..., :nf], u[..., nf:]
        return jnp.concatenate([u1 * cos - u2 * sin, u1 * sin + u2 * cos], axis=-1)

    return jnp.concatenate([rotate(t[..., :half], rows), rotate(t[..., half:], cols)], axis=-1)


def gla_scan(q, k, v, log_a, s0):
    b, h, l, dk = q.shape
    dv = v.shape[-1]
    n = l // GLA_CHUNK
    qc = q.reshape(b, h, n, GLA_CHUNK, dk)
    kc = k.reshape(b, h, n, GLA_CHUNK, dk)
    vc = v.reshape(b, h, n, GLA_CHUNK, dv)
    cum = jnp.cumsum(log_a.reshape(b, h, n, GLA_CHUNK, dk), axis=3)
    cum_end = cum[:, :, :, -1:, :]
    q_dec = qc * jnp.exp(cum)
    k_inv = kc * jnp.exp(-cum)
    k_end = kc * jnp.exp(cum_end - cum)
    tril = jnp.tril(jnp.ones((GLA_CHUNK, GLA_CHUNK), dtype=bool))
    scores = jnp.where(tril, jnp.einsum('bhnid,bhnjd->bhnij', q_dec, k_inv), 0.0)
    o_intra = jnp.einsum('bhnij,bhnjv->bhniv', scores, vc)
    ds = jnp.einsum('bhncd,bhncv->nbhdv', k_end, vc)
    decay = jnp.moveaxis(jnp.exp(cum_end[:, :, :, 0, :]), 2, 0)

    def step(s, inp):
        g, d = inp
        return g[..., None] * s + d, s

    s_fin, s_prev = lax.scan(step, s0, (decay, ds))
    o_inter = jnp.einsum('bhncd,nbhdv->bhncv', q_dec, s_prev)
    return (o_intra + o_inter).reshape(b, h, l, dv), s_fin


def gla_bidir(q, k, v, la_f, la_b, s0_f, s0_b):
    o_f, s_f = gla_scan(q, k, v, la_f, s0_f)
    o_b, s_b = gla_scan(jnp.flip(q, 2), jnp.flip(k, 2), jnp.flip(v, 2), jnp.flip(la_b, 2), s0_b)
    return o_f + jnp.flip(o_b, 2), s_f, s_b


def gla_inputs(gq, gk, gv, gz, w_gate, b_gate, rows=None, cols=None):
    b, l, _ = gq.shape
    q = to_heads(gq, GLA_HEADS).astype(F32) * GLA_DK ** -0.5
    k = to_heads(gk, GLA_HEADS).astype(F32)
    if rows is not None:
        q = axial_rope(q, rows, cols)
        k = axial_rope(k, rows, cols)
    v = to_heads(gv, GLA_HEADS).astype(F32)
    z = gz.astype(F32).reshape(b, l, 2, GLA_GATE_RANK)
    la = jax.nn.log_sigmoid(jnp.einsum('blur,urk->ublk', z, w_gate.astype(F32))
                            + b_gate.astype(F32)[:, None, None, :]) / GLA_TAU
    return q, k, v, to_heads(la[0], GLA_HEADS), to_heads(la[1], GLA_HEADS)


def gla_output(o, gr, gain):
    on = o * lax.rsqrt(jnp.mean(o * o, axis=-1, keepdims=True) + EPS) * gain.astype(F32)
    return from_heads(on) * jax.nn.silu(gr.astype(F32))


def hyena_filter_freq(l, w1, b1, w2, b2, w3, freq):
    t = jnp.linspace(0.0, 1.0, l, dtype=F32)[:, None]
    w = (2.0 * math.pi / l) * jnp.arange(l, dtype=F32)[:, None]
    f = jnp.linspace(1e-4, HY_BANDS - 1, HY_BANDS, dtype=F32)[None, :]
    z = jnp.concatenate([t, jnp.cos(f * w), -jnp.sin(f * w)], axis=-1)
    freq = freq.astype(F32)
    h = jnp.sin(freq[0] * (z @ w1.astype(F32) + b1.astype(F32)))
    h = jnp.sin(freq[1] * (h @ w2.astype(F32) + b2.astype(F32)))
    h = (h @ w3.astype(F32)).reshape(l, 2, HY_WIDTH)
    deltas = jnp.abs(jnp.linspace(math.log(HY_DECAY_TARGET) / HY_SLOW_PCT,
                                  math.log(HY_DECAY_TARGET) / HY_FAST_PCT, HY_WIDTH, dtype=F32))
    h = h * (jnp.exp(-t * deltas) + HY_DECAY_SHIFT)[:, None, :]
    h = h / (jnp.sum(jnp.abs(h), axis=(0, 1), keepdims=True) + EPS)
    fwd, bwd = h[:, 0], h[:, 1]
    kern = jnp.concatenate([fwd[:1] + bwd[:1], fwd[1:], jnp.zeros((1, HY_WIDTH), F32),
                            jnp.flip(bwd[1:], axis=0)], axis=0)
    return jnp.fft.rfft(kern, axis=0)


def hyena_mixer(hy, conv_w, conv_b, w1, b1, w2, b2, w3, freq, bias):
    l = hy.shape[1]
    u = dwconv(hy, conv_w, conv_b).astype(F32)
    x0, x1, v = jnp.split(u, 3, axis=-1)
    kf = hyena_filter_freq(l, w1, b1, w2, b2, w3, freq)
    s = v * x1
    sf = jnp.fft.rfft(s, n=2 * l, axis=1)
    y = jnp.fft.irfft(sf * kf[None], n=2 * l, axis=1)[:, :l] + s * bias.astype(F32)
    return y * x0


def fourier_mixer(u, w):
    b, l, _ = u.shape
    ug = u.astype(F32).reshape(b, l, FN_GROUPS, FN_DG)
    f = jnp.fft.fft2(ug, axes=(1, 3), norm='ortho').real
    return jnp.einsum('blgd,gde->blge', f, w.astype(F32)).reshape(b, l, FN_WIDTH)


def natten_latent(q, k, v, k_ctx, v_ctx, rpb):
    b, h, l, dh = q.shape
    n_rows = l // GRID_W
    kr = min(NA_KR_MAX, n_rows)
    scale = dh ** -0.5
    qg = q.reshape(b, h, n_rows, GRID_W, dh)
    kg = k.reshape(b, h, n_rows, GRID_W, dh)
    vg = v.reshape(b, h, n_rows, GRID_W, dh)
    r = jnp.arange(n_rows)
    col = jnp.arange(GRID_W)
    row_idx = jnp.clip(r - kr // 2, 0, n_rows - kr)[:, None] + jnp.arange(kr)[None, :]
    col0 = jnp.clip(col - NA_KC // 2, 0, GRID_W - NA_KC)
    k_rows = kg[:, :, row_idx]
    v_rows = vg[:, :, row_idx]
    s_loc = jnp.einsum('bhrqd,bhrikd->bhrqik', qg, k_rows).astype(F32) * scale
    d_row = row_idx - r[:, None]
    d_col = col[None, :] - col[:, None]
    in_win = (col[None, :] >= col0[:, None]) & (col[None, :] < col0[:, None] + NA_KC)
    bias = rpb.astype(F32)[:, (d_row + NA_KR_MAX - 1)[:, None, :, None],
                           jnp.clip(d_col + NA_KC - 1, 0, 2 * NA_KC - 2)[None, :, None, :]]
    s_loc = jnp.where(in_win[:, None, :], s_loc + bias[None], -jnp.inf)
    s_ctx = jnp.einsum('bhrqd,bhcd->bhrqc', qg, k_ctx).astype(F32) * scale
    n_loc = kr * GRID_W
    p = jax.nn.softmax(jnp.concatenate([s_loc.reshape(b, h, n_rows, GRID_W, n_loc), s_ctx], axis=-1),
                       axis=-1).astype(v.dtype)
    p_loc = p[..., :n_loc].reshape(b, h, n_rows, GRID_W, kr, GRID_W)
    out = (jnp.einsum('bhrqik,bhrikd->bhrqd', p_loc, v_rows)
           + jnp.einsum('bhrqc,bhcd->bhrqd', p[..., n_loc:], v_ctx))
    return out.reshape(b, h, l, dh)


def ctx_attention(q, k, v):
    s = jnp.einsum('bhqd,bhkd->bhqk', q, k).astype(F32) * q.shape[-1] ** -0.5
    p = jax.nn.softmax(s, axis=-1).astype(v.dtype)
    return jnp.einsum('bhqk,bhkd->bhqd', p, v)


def conv_ffn(h, w_up, conv_w, conv_b, w_down):
    u = dwconv(h @ w_up, conv_w, conv_b)
    a, g = jnp.split(u, 2, axis=-1)
    return (a * jax.nn.silu(g)) @ w_down


def setup_inputs(seed: int = 0) -> dict:
    key = jax.random.key(seed)
    ks = iter(jax.random.split(key, 40))

    def nrm(shape, scale):
        return scale * jax.random.normal(next(ks), shape, F32)

    def gain(shape):
        return 1.0 + 0.02 * jax.random.normal(next(ks), shape, F32)

    return {
        'x': nrm((BATCH, SEQ, D_MODEL), 1.0),
        'c': nrm((BATCH, D_MODEL), 1.0),
        'ctx': nrm((BATCH, CTX_LEN, D_MODEL), 1.0),
        'c_ctx': nrm((D_MODEL,), 1.0),
        'w_mod': nrm((DEPTH, D_MODEL, N_MOD * D_MODEL), 0.5 * D_MODEL ** -0.5),
        'b_mod': nrm((DEPTH, N_MOD * D_MODEL), 0.01),
        'g_mix': gain((DEPTH, D_MODEL)),
        'w_in': nrm((DEPTH, D_MODEL, D_IN), D_MODEL ** -0.5),
        'gla_gate_w': nrm((DEPTH, 2, GLA_GATE_RANK, GLA_HEADS * GLA_DK), GLA_GATE_RANK ** -0.5),
        'gla_gate_b': nrm((DEPTH, 2, GLA_HEADS * GLA_DK), 0.1),
        'gla_out_g': gain((DEPTH, GLA_DV)),
        'hy_conv_w': nrm((DEPTH, HY_SHORT, 3 * HY_WIDTH), HY_SHORT ** -0.5),
        'hy_conv_b': nrm((DEPTH, 3 * HY_WIDTH), 0.01),
        'hy_w1': nrm((DEPTH, HY_EMB, HY_FILT_HIDDEN), HY_EMB ** -0.5),
        'hy_b1': nrm((DEPTH, HY_FILT_HIDDEN), 0.1),
        'hy_w2': nrm((DEPTH, HY_FILT_HIDDEN, HY_FILT_HIDDEN), HY_FILT_HIDDEN ** -0.5),
        'hy_b2': nrm((DEPTH, HY_FILT_HIDDEN), 0.1),
        'hy_w3': nrm((DEPTH, HY_FILT_HIDDEN, 2 * HY_WIDTH), HY_FILT_HIDDEN ** -0.5),
        'hy_freq': gain((DEPTH, 2, HY_FILT_HIDDEN)),
        'hy_bias': nrm((DEPTH, HY_WIDTH), 0.5),
        'fn_w': nrm((DEPTH, FN_GROUPS, FN_DG, FN_DG), FN_DG ** -0.5),
        'na_q_g': gain((DEPTH, NA_DH)),
        'na_k_g': gain((DEPTH, NA_DH)),
        'na_rpb': nrm((DEPTH, NA_HEADS, 2 * NA_KR_MAX - 1, 2 * NA_KC - 1), 0.1),
        'w_out': nrm((DEPTH, D_MIX, D_MODEL), D_MIX ** -0.5),
        'g_ffn': gain((DEPTH, D_MODEL)),
        'ffn_w_up': nrm((DEPTH, D_MODEL, 2 * D_FF), D_MODEL ** -0.5),
        'ffn_conv_w': nrm((DEPTH, FFN_CONV, 2 * D_FF), FFN_CONV ** -0.5),
        'ffn_conv_b': nrm((DEPTH, 2 * D_FF), 0.01),
        'ffn_w_down': nrm((DEPTH, D_FF, D_MODEL), D_FF ** -0.5),
    }


def reference(x, c, ctx, c_ctx, w_mod, b_mod, g_mix, w_in, gla_gate_w, gla_gate_b, gla_out_g,
              hy_conv_w, hy_conv_b, hy_w1, hy_b1, hy_w2, hy_b2, hy_w3, hy_freq, hy_bias, fn_w,
              na_q_g, na_k_g, na_rpb, w_out, g_ffn, ffn_w_up, ffn_conv_w, ffn_conv_b, ffn_w_down):
    l_lat = x.shape[1]
    t = jnp.arange(l_lat)
    rows, cols = t // GRID_W, t % GRID_W
    split_at = np.cumsum(IN_SPLITS)[:-1].tolist()
    s_c = jax.nn.silu(c)
    s_cc = jax.nn.silu(c_ctx)
    for layer in range(DEPTH):
        last = layer == DEPTH - 1
        mod_x = jnp.split((s_c @ w_mod[layer] + b_mod[layer])[:, None, :], N_MOD, axis=-1)
        mod_c = jnp.split((s_cc @ w_mod[layer] + b_mod[layer])[None, None, :], N_MOD, axis=-1)
        hx = modulate(rms_norm(x, g_mix[layer]), mod_x[0], mod_x[1])
        hc = modulate(rms_norm(ctx, g_mix[layer]), mod_c[0], mod_c[1])
        gq, gk, gv, gr, gz, hy, fnu, nq, nk, nv = jnp.split(hx @ w_in[layer], split_at, axis=-1)
        cq, ck, cv, cr, cz, chy, cfn, cnq, cnk, cnv = jnp.split(hc @ w_in[layer], split_at, axis=-1)

        s0 = jnp.zeros((ctx.shape[0], GLA_HEADS, GLA_DK, GLA_DV), F32)
        o_ac, s_f, s_b = gla_bidir(*gla_inputs(cq, ck, cv, cz, gla_gate_w[layer], gla_gate_b[layer]), s0, s0)
        o_ax, _, _ = gla_bidir(*gla_inputs(gq, gk, gv, gz, gla_gate_w[layer], gla_gate_b[layer], rows, cols),
                               s_f, s_b)
        y_a = gla_output(o_ax, gr, gla_out_g[layer])
        y_b = hyena_mixer(hy, hy_conv_w[layer], hy_conv_b[layer], hy_w1[layer], hy_b1[layer], hy_w2[layer],
                          hy_b2[layer], hy_w3[layer], hy_freq[layer], hy_bias[layer])
        y_c = fourier_mixer(fnu, fn_w[layer])
        k_ctx = rms_norm(to_heads(cnk, NA_HEADS), na_k_g[layer])
        v_ctx = to_heads(cnv, NA_HEADS)
        y_d = from_heads(natten_latent(rms_norm(to_heads(nq, NA_HEADS), na_q_g[layer]),
                                       rms_norm(to_heads(nk, NA_HEADS), na_k_g[layer]),
                                       to_heads(nv, NA_HEADS), k_ctx, v_ctx, na_rpb[layer]))
        y = jnp.concatenate([y_a.astype(x.dtype), y_b.astype(x.dtype), y_c.astype(x.dtype),
                             y_d.astype(x.dtype)], axis=-1) @ w_out[layer]
        x = x + mod_x[2] * y
        x = x + mod_x[5] * conv_ffn(modulate(rms_norm(x, g_ffn[layer]), mod_x[3], mod_x[4]),
                                    ffn_w_up[layer], ffn_conv_w[layer], ffn_conv_b[layer], ffn_w_down[layer])

        if not last:
            yc_a = gla_output(o_ac, cr, gla_out_g[layer])
            yc_b = hyena_mixer(chy, hy_conv_w[layer], hy_conv_b[layer], hy_w1[layer], hy_b1[layer],
                               hy_w2[layer], hy_b2[layer], hy_w3[layer], hy_freq[layer], hy_bias[layer])
            yc_c = fourier_mixer(cfn, fn_w[layer])
            yc_d = from_heads(ctx_attention(rms_norm(to_heads(cnq, NA_HEADS), na_q_g[layer]), k_ctx, v_ctx))
            yc = jnp.concatenate([yc_a.astype(ctx.dtype), yc_b.astype(ctx.dtype), yc_c.astype(ctx.dtype),
                                  yc_d.astype(ctx.dtype)], axis=-1) @ w_out[layer]
            ctx = ctx + mod_c[2] * yc
            ctx = ctx + mod_c[5] * conv_ffn(modulate(rms_norm(ctx, g_ffn[layer]), mod_c[3], mod_c[4]),
                                            ffn_w_up[layer], ffn_conv_w[layer], ffn_conv_b[layer],
                                            ffn_w_down[layer])
    return x
```

```cpp
#include <hip/hip_runtime.h>
#include <hip/hip_cooperative_groups.h>
#include <cstdio>
namespace cg = cooperative_groups;

#define LAS __attribute__((address_space(3)))
typedef unsigned short bf16_t;
typedef short bf16x8 __attribute__((ext_vector_type(8)));
typedef float f32x4 __attribute__((ext_vector_type(4)));
typedef unsigned u32x4 __attribute__((ext_vector_type(4)));
typedef unsigned u32x2 __attribute__((ext_vector_type(2)));

constexpr int D = 2048, NB = 16, LS = 2048, LC = 256, NLAT = NB * LS, NCTX = NB * LC, NTOK = NLAT + NCTX;
constexpr int NP = 5376, DFF = 5632, DFF2 = 11264, NMOD = 12288, LALL = LS + LC;
constexpr int C_GQ = 0, C_GK = 256, C_GV = 512, C_GR = 1024, C_HY = 1536, C_FN = 3072, C_NQ = 3584, C_NK = 4096, C_NV = 4608, C_GZ = 5120;
constexpr float EPSF = 1e-6f;
constexpr int NTHR = 512;
constexpr int LDS_BYTES = 163840;

constexpr size_t al256(size_t x) { return (x + 255) & ~(size_t)255; }
constexpr size_t WS_WTIN = 0;
constexpr size_t WS_WTOUT = WS_WTIN + al256((size_t)NP * D * 2);
constexpr size_t WS_WTUP = WS_WTOUT + al256((size_t)D * D * 2);
constexpr size_t WS_WTDN = WS_WTUP + al256((size_t)DFF2 * D * 2);
constexpr size_t WS_CX = WS_WTDN + al256((size_t)D * DFF * 2);
constexpr size_t WS_HY = WS_CX + al256((size_t)NCTX * D * 4);
constexpr size_t WS_MODP = WS_HY + al256((size_t)NTOK * D * 2);
constexpr size_t WS_MOD = WS_MODP + al256((size_t)2 * 8 * 17 * NMOD * 4);
constexpr size_t WS_HFT = WS_MOD + al256((size_t)2 * 17 * NMOD * 4);
constexpr size_t WS_NORMP = WS_HFT + al256((size_t)2 * 2 * 512 * LALL * 4);
constexpr size_t WS_HNORM = WS_NORMP + al256((size_t)2 * 288 * 512 * 4);
constexpr size_t WS_CSW = WS_HNORM + al256((size_t)2 * 2 * 512 * 4);
constexpr size_t WS_DFT = WS_CSW + al256((size_t)2 * 4 * 256 * 256 * 2);
constexpr size_t WS_DFTC = WS_DFT + al256((size_t)2048 * 4096 * 2);
constexpr size_t WS_WCB = WS_DFTC + al256((size_t)256 * 512 * 2);
constexpr size_t WS_BIG = WS_WCB + al256((size_t)2 * DFF * 8 * 4);
constexpr size_t WS_PROJ = WS_BIG;
constexpr size_t WS_OGLA = WS_PROJ + al256((size_t)NTOK * NP * 2);
constexpr size_t WS_ST = WS_OGLA + al256((size_t)NTOK * 512 * 4);
constexpr size_t WS_UT = WS_ST + al256((size_t)512 * 16 * LALL * 2);
constexpr size_t WS_UTC = WS_UT + al256((size_t)8192 * 4096 * 2);
constexpr size_t WS_QN = WS_UTC + al256((size_t)8192 * 512 * 2);
constexpr size_t WS_KN = WS_QN + al256((size_t)NB * LALL * 512 * 2);
constexpr size_t WS_VT = WS_KN + al256((size_t)NB * LALL * 512 * 2);
constexpr size_t WS_END_MIX = WS_VT + al256((size_t)NB * LALL * 512 * 2);
constexpr size_t WS_ACT = WS_BIG;
constexpr size_t WS_EDGE = WS_ACT + al256((size_t)NTOK * DFF * 2);
constexpr size_t WS_END_FFN = WS_EDGE + al256((size_t)(NTOK / 256) * 4 * 2 * DFF * 4);
constexpr size_t WS_NEED = WS_END_MIX > WS_END_FFN ? WS_END_MIX : WS_END_FFN;
static_assert(WS_NEED <= (size_t)1073741824, "workspace plan exceeds 1 GiB");

struct Params {
  const float* in[30];
  float* out;
  unsigned char* ws;
};

typedef const __attribute__((address_space(4))) Params* PP;

__device__ __forceinline__ int ltid() { int t = threadIdx.x; asm volatile("" : "+v"(t)); return t; }
typedef float f32x2_t __attribute__((ext_vector_type(2)));
typedef __bf16 bf16x2_t __attribute__((ext_vector_type(2)));
__device__ __forceinline__ unsigned cvt_pk_bf16(float lo, float hi) { f32x2_t v; v[0] = lo; v[1] = hi; return __builtin_bit_cast(unsigned, __builtin_convertvector(v, bf16x2_t)); }
__device__ __forceinline__ bf16_t f2bf(float f) { return (bf16_t)(cvt_pk_bf16(f, 0.f) & 0xffffu); }
__device__ __forceinline__ float bf2f(bf16_t h) { return __uint_as_float(((unsigned)h) << 16); }
__device__ __forceinline__ unsigned pk2(float lo, float hi) { return cvt_pk_bf16(lo, hi); }
__device__ __forceinline__ float lo_bf(unsigned u) { return __uint_as_float(u << 16); }
__device__ __forceinline__ float hi_bf(unsigned u) { return __uint_as_float(u & 0xffff0000u); }
__device__ __forceinline__ float siluf(float v) { return v * __builtin_amdgcn_rcpf(1.f + __expf(-v)); }
#define LBAR() asm volatile("s_waitcnt lgkmcnt(0)\n\ts_barrier" ::: "memory")
__device__ __forceinline__ float shfl_xor_l(float v, int m) { const int l = ltid() & 63; return __builtin_bit_cast(float, __builtin_amdgcn_ds_bpermute((l ^ m) << 2, __builtin_bit_cast(int, v))); }
__device__ __forceinline__ float wave_sum(float v) {
#pragma unroll
  for (int m = 32; m >= 1; m >>= 1) v += shfl_xor_l(v, m);
  return v;
}

constexpr int BM = 256, BK = 64, HALF = 128, HTB = HALF * BK * 2, NXCD = 8, WGM = 8;
__device__ __forceinline__ int lds_byte(int r, int c) { const int st = (r >> 4) * 2 + (c >> 5), rr = r & 15, cc = c & 31, ob = rr * 64 + cc * 2; return st * 1024 + (ob ^ (((ob >> 9) & 1) << 5)); }
__device__ __forceinline__ void stage_rc(int b, int& R, int& C) { const int st = b / 1024, sb = b % 1024, swz = sb ^ (((sb >> 9) & 1) << 5); R = (st >> 1) * 16 + swz / 64; C = (st & 1) * 32 + (swz % 64) / 2; }
__device__ __forceinline__ int perm32(int rho) { const int n = rho >> 4, i = rho & 15; return 8 * (i >> 2) + 4 * n + (i & 3); }

struct Unit { const char* a; const char* b; int pm, pn; size_t o_off; int ld; size_t rbs; };

struct SchedStd {
  const char* A; const char* B; size_t tstepA, tstepB, bstep_pm, ostep_pm, rbs; int nM, nN, nwg, G, c, pm_off; int ld;
  __device__ __forceinline__ bool next(int i, Unit& u) const {
    const long L = (long)i * G + c; if (L >= nwg) return false;
    int wgid = (int)L; { const int q = nwg / NXCD, r = nwg % NXCD, xcd = wgid % NXCD, off = wgid / NXCD; wgid = (xcd < r ? xcd * (q + 1) : r * (q + 1) + (xcd - r) * q) + off; }
    const int nig = WGM * nN, gid = wgid / nig, fm = gid * WGM, gsz = (nM - fm) < WGM ? (nM - fm) : WGM;
    const int pm = fm + ((wgid % nig) % gsz), pn = (wgid % nig) / gsz;
    u.a = A + (size_t)pm * tstepA; u.b = B + (size_t)pn * tstepB + (size_t)pm * bstep_pm; u.pm = pm + pm_off; u.pn = pn; u.o_off = (size_t)pm * ostep_pm; u.ld = ld; u.rbs = rbs; return true;
  }
};


struct EpiBf16 {
  static constexpr bool PERM = true;
  bf16_t* O; int rb_shift; int cb_shift; size_t cbs; int rowmask;
  __device__ __forceinline__ void operator()(const f32x4 (&acc)[2][2][4][2], const Unit& u, int wr, int wc, int fr, int fq) const {
    const int row0 = u.pm * BM + wr * 64 + fr, col0 = u.pn * BM + wc * 32 + 8 * fq;
#pragma unroll
    for (int ai = 0; ai < 2; ++ai)
#pragma unroll
      for (int m = 0; m < 4; ++m) {
        const int row = (row0 + ai * HALF + m * 16) & rowmask;
        const size_t rbase = u.o_off + (size_t)(row & ((1 << rb_shift) - 1)) * u.ld + (size_t)(row >> rb_shift) * u.rbs;
#pragma unroll
        for (int bj = 0; bj < 2; ++bj) {
          const int col = col0 + bj * HALF;
          const size_t off = rbase + (size_t)(col & ((1 << cb_shift) - 1)) + (size_t)(col >> cb_shift) * cbs;
          const f32x4 v0 = acc[ai][bj][m][0], v1 = acc[ai][bj][m][1];
          u32x4 pk; pk[0] = cvt_pk_bf16(v0[0], v0[1]); pk[1] = cvt_pk_bf16(v0[2], v0[3]); pk[2] = cvt_pk_bf16(v1[0], v1[1]); pk[3] = cvt_pk_bf16(v1[2], v1[3]);
          *(u32x4*)(O + off) = pk;
        }
      }
  }
};

struct EpiResid {
  static constexpr bool PERM = false;
  float* out; float* cx; const float* gate; float scale;
  __device__ __forceinline__ void operator()(const f32x4 (&acc)[2][2][4][2], const Unit& u, int wr, int wc, int fr, int fq) const {
    const int row0 = u.pm * BM + wr * 64 + fr, col0 = u.pn * BM + wc * 32 + 4 * fq;
#pragma unroll
    for (int ai = 0; ai < 2; ++ai)
#pragma unroll
      for (int m = 0; m < 4; ++m) {
        const int row = row0 + ai * HALF + m * 16;
        float* rowp = (row < NLAT ? out + (size_t)row * D : cx + (size_t)(row - NLAT) * D) + col0;
        const int mb = row < NLAT ? (row >> 11) : 16;
        const float* gp = gate + (size_t)mb * NMOD + col0;
#pragma unroll
        for (int bj = 0; bj < 2; ++bj)
#pragma unroll
          for (int n = 0; n < 2; ++n) {
            const f32x4 g = *(const f32x4*)(gp + bj * HALF + n * 16);
            f32x4 x = *(f32x4*)(rowp + bj * HALF + n * 16);
            x += (g * scale) * acc[ai][bj][m][n];
            *(f32x4*)(rowp + bj * HALF + n * 16) = x;
          }
      }
  }
};

template <int CTRL> __device__ __forceinline__ float dppf(float x) { return __builtin_bit_cast(float, __builtin_amdgcn_update_dpp(0, __builtin_bit_cast(int, x), CTRL, 0xf, 0xf, true)); }

struct EpiFFN {
  static constexpr bool PERM = true;
  bf16_t* ACT; float* EDGE; const float* wcb; LAS f32x4* halo;
  __device__ __forceinline__ void operator()(const f32x4 (&acc)[2][2][4][2], const Unit& u, int wr, int wc, int fr, int fq) const {
    const int wid = wr * 4 + wc;
    LAS float* wl = (LAS float*)halo + 2048 + wid * 256;
    if (fr == 0) {
#pragma unroll
      for (int ai = 0; ai < 2; ++ai)
#pragma unroll
        for (int bj = 0; bj < 2; ++bj)
#pragma unroll
          for (int n = 0; n < 2; ++n) halo[((((wid * 2 + 0) * 2 + ai) * 2 + bj) * 4 + fq) * 2 + n] = acc[ai][bj][0][n];
    }
    if (fr == 15) {
#pragma unroll
      for (int ai = 0; ai < 2; ++ai)
#pragma unroll
        for (int bj = 0; bj < 2; ++bj)
#pragma unroll
          for (int n = 0; n < 2; ++n) halo[((((wid * 2 + 1) * 2 + ai) * 2 + bj) * 4 + fq) * 2 + n] = acc[ai][bj][3][n];
    }
    { const f32x4 wslice = *(const f32x4*)(wcb + (size_t)(u.pn * 128 + wc * 32) * 8 + (fq * 16 + fr) * 4); *(LAS f32x4*)(wl + (fq * 16 + fr) * 4) = wslice; }
    asm volatile("s_waitcnt lgkmcnt(0)" ::: "memory");
    __builtin_amdgcn_s_barrier(); __builtin_amdgcn_s_barrier();
    asm volatile("" ::: "memory");
    const int jb = u.pn * 128 + wc * 32 + 8 * fq;
    const int trow0 = wr * 64 + fr;
    const LAS float* hf = (const LAS float*)halo;
    const LAS float* wrow = wl + 8 * fq * 8;
#pragma unroll
    for (int n = 0; n < 2; ++n) {
      const int j = jb + 4 * n;
#pragma unroll
      for (int ai = 0; ai < 2; ++ai) {
        const bool hasp = (wr == 1) || (ai == 1), hasn = (wr == 0) || (ai == 0);
        const int pw = (wr == 1) ? wc : 4 + wc, pai = (wr == 1) ? ai : 0;
        const int nw = (wr == 0) ? 4 + wc : wc, nai = (wr == 0) ? ai : 1;
        unsigned actp[4][2]; float alo[4];
#pragma unroll
        for (int e = 0; e < 4; ++e) {
          const f32x4 wa = *(const LAS f32x4*)(wrow + (4 * n + e) * 8), wg = *(const LAS f32x4*)(wrow + (4 * n + e) * 8 + 4);
          const float hpa_ = hf[(((((pw * 2 + 1) * 2 + pai) * 2 + 0) * 4 + fq) * 2 + n) * 4 + e], hpg_ = hf[(((((pw * 2 + 1) * 2 + pai) * 2 + 1) * 4 + fq) * 2 + n) * 4 + e];
          const float hna_ = hf[(((((nw * 2 + 0) * 2 + nai) * 2 + 0) * 4 + fq) * 2 + n) * 4 + e], hng_ = hf[(((((nw * 2 + 0) * 2 + nai) * 2 + 1) * 4 + fq) * 2 + n) * 4 + e];
          const float hpa = hasp ? hpa_ : 0.f, hpg = hasp ? hpg_ : 0.f, hna = hasn ? hna_ : 0.f, hng = hasn ? hng_ : 0.f;
#pragma unroll
          for (int m = 0; m < 4; ++m) {
            float cva, cvg;
            {
              const float cur = acc[ai][0][m][n][e];
              const float su = dppf<0x111>(cur), sd = dppf<0x101>(cur);
              const float wu = m > 0 ? dppf<0x121>(acc[ai][0][m > 0 ? m - 1 : 0][n][e]) : hpa;
              const float wd = m < 3 ? dppf<0x12F>(acc[ai][0][m < 3 ? m + 1 : 3][n][e]) : hna;
              const float up = fr == 0 ? wu : su, dn = fr == 15 ? wd : sd;
              cva = wa[0] + wa[1] * up + wa[2] * cur + wa[3] * dn;
            }
            {
              const float cur = acc[ai][1][m][n][e];
              const float su = dppf<0x111>(cur), sd = dppf<0x101>(cur);
              const float wu = m > 0 ? dppf<0x121>(acc[ai][1][m > 0 ? m - 1 : 0][n][e]) : hpg;
              const float wd = m < 3 ? dppf<0x12F>(acc[ai][1][m < 3 ? m + 1 : 3][n][e]) : hng;
              const float up = fr == 0 ? wu : su, dn = fr == 15 ? wd : sd;
              cvg = wg[0] + wg[1] * up + wg[2] * cur + wg[3] * dn;
            }
            float av = cva * siluf(cvg);
            asm volatile("" : "+v"(av));
            if (e & 1) actp[m][e >> 1] = cvt_pk_bf16(alo[m], av); else alo[m] = av;
            if (m == 3 && (e & 1)) __builtin_amdgcn_sched_barrier(0);
          }
        }
#pragma unroll
        for (int m = 0; m < 4; ++m) {
          int trow = ai * 128 + trow0 + m * 16;
          asm volatile("" : "+v"(trow));
          const size_t row = (size_t)u.pm * BM + trow;
          if (trow != 0 && trow != 255) {
            u32x2 pk; pk[0] = actp[m][0]; pk[1] = actp[m][1];
            *(u32x2*)(ACT + row * DFF + j) = pk;
          }
          if (trow < 2 || trow >= 254) {
            const int k = trow < 2 ? trow : trow - 252;
            float* ep = EDGE + ((size_t)(u.pm * 4 + k) * 2) * DFF + j;
            *(f32x4*)ep = acc[ai][0][m][n];
            *(f32x4*)(ep + DFF) = acc[ai][1][m][n];
          }
        }
        __builtin_amdgcn_sched_barrier(0);
      }
    }
  }
};

template <class Epi, class Sched>
__device__ __forceinline__ void gemm_phase(LAS unsigned char* lds, const int K, const int lda, const int ldb, const Sched& S, const Epi& E) {
  const int tid = ltid(), wid = __builtin_amdgcn_readfirstlane(tid >> 6), lane = tid & 63, wr = wid >> 2, wc = wid & 3, fr = lane & 15, fq = lane >> 4;
  const int nt = K / BK;
  unsigned voffA[2], voffB[2];
#pragma unroll
  for (int i = 0; i < 2; ++i) { int R, C; stage_rc(tid * 16 + i * 8192, R, C); const int Rb = Epi::PERM ? ((R & ~31) + perm32(R & 31)) : R;
    voffA[i] = (unsigned)(R * lda + C) * 2u; voffB[i] = (unsigned)(Rb * ldb + C) * 2u; }
  const size_t kstep = (size_t)(BK * 2);
  const size_t hstepA = (size_t)HALF * lda * 2, hstepB = (size_t)HALF * ldb * 2;
  const unsigned ldsw = (unsigned)wid * 1024u;
  const int aoff = lds_byte(wr * 64 + fr, fq * 8), boff = lds_byte(wc * 32 + fr, fq * 8);
#define G_SA(b, h) (((b) * 2 + (h)) * HTB)
#define G_SB(b, h) ((4 + (b) * 2 + (h)) * HTB)
#define G_STAGE(bufoff, gbase, voff) do { _Pragma("unroll") for (int _i = 0; _i < 2; ++_i) \
    __builtin_amdgcn_global_load_lds((const unsigned*)((const char*)(gbase) + (voff)[_i]), (LAS unsigned*)(lds + (bufoff) + ldsw + _i * 8192), 16, 0, 0); } while (0)
#define G_LDA(dst, b, h) do { _Pragma("unroll") for (int m = 0; m < 4; ++m) _Pragma("unroll") for (int k = 0; k < 2; ++k) dst[m][k] = *(const LAS bf16x8*)(lds + G_SA(b, h) + aoff + m * 2048 + k * 1024); } while (0)
#define G_LDB(dst, b, h) do { _Pragma("unroll") for (int n = 0; n < 2; ++n) _Pragma("unroll") for (int k = 0; k < 2; ++k) dst[n][k] = *(const LAS bf16x8*)(lds + G_SB(b, h) + boff + n * 2048 + k * 1024); } while (0)
#define G_MMA(ai, bj, At, Bt) do { __builtin_amdgcn_s_setprio(1); _Pragma("unroll") for (int m = 0; m < 4; ++m) _Pragma("unroll") for (int n = 0; n < 2; ++n) _Pragma("unroll") for (int k = 0; k < 2; ++k) \
    acc[ai][bj][m][n] = __builtin_amdgcn_mfma_f32_16x16x32_bf16(Bt[n][k], At[m][k], acc[ai][bj][m][n], 0, 0, 0); __builtin_amdgcn_s_setprio(0); } while (0)
#define G_WAIT_V(n) asm volatile("s_waitcnt vmcnt(" #n ")" ::: "memory")
#define G_WAIT_L(n) asm volatile("s_waitcnt lgkmcnt(" #n ")" ::: "memory")
#define G_BAR __builtin_amdgcn_s_barrier()
#define G_SCHED __builtin_amdgcn_sched_barrier(0)
  Unit cur, nxt; int ui = 0;
  if (!S.next(0, cur)) return;
  f32x4 acc[2][2][4][2];
#pragma unroll
  for (int a = 0; a < 2; ++a)
#pragma unroll
    for (int b = 0; b < 2; ++b)
#pragma unroll
      for (int m = 0; m < 4; ++m)
#pragma unroll
        for (int n = 0; n < 2; ++n) acc[a][b][m][n] = (f32x4){0.f, 0.f, 0.f, 0.f};
  bf16x8 At[4][2], B0[2][2], B1[2][2];
  const char* cA = cur.a; const char* cB = cur.b;
  G_STAGE(G_SB(0, 0), cB, voffB); G_STAGE(G_SA(0, 0), cA, voffA); G_STAGE(G_SB(0, 1), cB + hstepB, voffB); G_STAGE(G_SA(0, 1), cA + hstepA, voffA);
  if (wr == 1) G_BAR;
  G_WAIT_V(4); G_BAR;
  G_STAGE(G_SB(1, 0), cB + kstep, voffB); G_STAGE(G_SA(1, 0), cA + kstep, voffA); G_STAGE(G_SB(1, 1), cB + hstepB + kstep, voffB);
  G_WAIT_V(6); G_BAR;
  for (;;) {
    const bool has_next = S.next(ui + 1, nxt);
    const char* nA = has_next ? nxt.a : cA; const char* nB = has_next ? nxt.b : cB;
    for (int t = 0; t < nt; t += 2) {
      const bool last = (t == nt - 2);
      const char* a1 = cA + (size_t)(t + 1) * kstep;
      const char* a2 = last ? nA : cA + (size_t)(t + 2) * kstep; const char* b2 = last ? nB : cB + (size_t)(t + 2) * kstep;
      const char* a3 = a2 + kstep; const char* b3 = b2 + kstep;
      G_LDB(B0, 0, 0); G_SCHED; G_LDA(At, 0, 0); G_STAGE(G_SA(1, 1), a1 + hstepA, voffA);
      G_WAIT_L(8); G_BAR; G_WAIT_L(0); G_MMA(0, 0, At, B0); G_BAR; G_SCHED;
      G_LDB(B1, 0, 1); G_STAGE(G_SB(0, 0), b2, voffB);
      G_BAR; G_WAIT_L(0); G_MMA(0, 1, At, B1); G_BAR;
      G_LDA(At, 0, 1); G_STAGE(G_SA(0, 0), a2, voffA);
      G_BAR; G_WAIT_L(0); G_MMA(1, 0, At, B0); G_BAR; G_SCHED;
      G_STAGE(G_SB(0, 1), b2 + hstepB, voffB);
      G_WAIT_V(6); G_BAR; G_MMA(1, 1, At, B1); G_BAR;
      G_LDB(B0, 1, 0); G_SCHED; G_LDA(At, 1, 0); G_STAGE(G_SA(0, 1), a2 + hstepA, voffA);
      G_WAIT_L(8); G_BAR; G_WAIT_L(0); G_MMA(0, 0, At, B0); G_BAR; G_SCHED;
      G_LDB(B1, 1, 1); G_STAGE(G_SB(1, 0), b3, voffB);
      G_BAR; G_WAIT_L(0); G_MMA(0, 1, At, B1); G_BAR;
      G_LDA(At, 1, 1); G_STAGE(G_SA(1, 0), a3, voffA);
      G_BAR; G_WAIT_L(0); G_MMA(1, 0, At, B0); G_BAR; G_SCHED;
      G_STAGE(G_SB(1, 1), b3 + hstepB, voffB);
      G_WAIT_V(6); G_BAR; G_MMA(1, 1, At, B1); G_BAR;
    }
    E(acc, cur, wr, wc, fr, fq);
    if (!has_next) break;
#pragma unroll
    for (int a = 0; a < 2; ++a)
#pragma unroll
      for (int b = 0; b < 2; ++b)
#pragma unroll
        for (int m = 0; m < 4; ++m)
#pragma unroll
          for (int n = 0; n < 2; ++n) acc[a][b][m][n] = (f32x4){0.f, 0.f, 0.f, 0.f};
    cur = nxt; cA = nA; cB = nB; ++ui;
  }
  G_WAIT_V(0);
  if (wr == 0) G_BAR;
  G_BAR;
#undef G_SA
#undef G_SB
#undef G_STAGE
#undef G_LDA
#undef G_LDB
#undef G_MMA
}

struct WtItem { const float* W; bf16_t* Wt; int ldw, K, k0, n0, mode; };
__device__ __forceinline__ void wt_decode(PP p, int layer, int it, WtItem& w) {
  constexpr int N_IN = 32 * 21, N_OUT = 32 * 8, N_UP = 32 * 44;
  if (it < N_IN) { w.W = p->in[7] + (size_t)layer * D * 5152; w.Wt = (bf16_t*)(p->ws + WS_WTIN); w.ldw = 5152; w.K = D; w.k0 = (it & 31) * 64; w.n0 = (it >> 5) * 256; w.mode = 1; }
  else if (it < N_IN + N_OUT) { const int j = it - N_IN; w.W = p->in[24] + (size_t)layer * D * D; w.Wt = (bf16_t*)(p->ws + WS_WTOUT); w.ldw = D; w.K = D; w.k0 = (j & 31) * 64; w.n0 = (j >> 5) * 256; w.mode = 0; }
  else if (it < N_IN + N_OUT + N_UP) { const int j = it - N_IN - N_OUT; w.W = p->in[26] + (size_t)layer * D * DFF2; w.Wt = (bf16_t*)(p->ws + WS_WTUP); w.ldw = DFF2; w.K = D; w.k0 = (j & 31) * 64; w.n0 = (j >> 5) * 256; w.mode = 2; }
  else { const int j = it - N_IN - N_OUT - N_UP; w.W = p->in[29] + (size_t)layer * DFF * D; w.Wt = (bf16_t*)(p->ws + WS_WTDN); w.ldw = D; w.K = DFF; w.k0 = (j % 88) * 64; w.n0 = (j / 88) * 256; w.mode = 0; }
}
__device__ __forceinline__ void wt_load(const WtItem& w, int tid, f32x4 (&v)[8]) {
  const int n = w.n0 + (tid & 63) * 4;
  int ns = n;
  if (w.mode == 1) ns = (n < 1536) ? n : (n < 5120 ? n + 32 : (n < 5152 ? 1536 + (n - 5120) : -1));
  if (w.mode == 2) ns = ((n >> 7) & 1) * DFF + (n >> 8) * 128 + (n & 127);
  const float* src = w.W + (size_t)(w.k0 + (tid >> 6)) * w.ldw + (ns >= 0 ? ns : 0);
#pragma unroll
  for (int i = 0; i < 8; ++i) { const f32x4 zz = {0.f, 0.f, 0.f, 0.f}; v[i] = ns >= 0 ? *(const f32x4*)(src + (size_t)(8 * i) * w.ldw) : zz; }
}
__device__ __forceinline__ void phase_weights(PP p, int layer, LAS unsigned char* lds) {
  constexpr int WS_ = 258;
  LAS bf16_t* tile = (LAS bf16_t*)lds;
  constexpr int NT = 32 * 21 + 32 * 8 + 32 * 44 + 88 * 8;
  const int tid = ltid();
  int it = blockIdx.x;
  if (it >= NT) return;
  WtItem cur; wt_decode(p, layer, it, cur);
  f32x4 v[8]; wt_load(cur, tid, v);
  for (;;) {
    const int nit = it + gridDim.x; const bool has = nit < NT;
    WtItem nxt = cur; f32x4 vn[8];
    __syncthreads();
#pragma unroll
    for (int i = 0; i < 8; ++i) {
      LAS unsigned* dst = (LAS unsigned*)(tile + ((tid >> 6) + 8 * i) * WS_ + (tid & 63) * 4);
      dst[0] = pk2(v[i][0], v[i][1]); dst[1] = pk2(v[i][2], v[i][3]);
    }
    if (has) { wt_decode(p, layer, nit, nxt); wt_load(nxt, tid, vn); }
    __syncthreads();
#pragma unroll
    for (int j = 0; j < 4; ++j) {
      const int pc_ = tid + 512 * j; const int n2 = pc_ >> 3, k8 = (pc_ & 7) * 8;
      u32x4 o;
#pragma unroll
      for (int e = 0; e < 4; ++e) o[e] = (unsigned)tile[(k8 + 2 * e) * WS_ + n2] | ((unsigned)tile[(k8 + 2 * e + 1) * WS_ + n2] << 16);
      *(u32x4*)(cur.Wt + (size_t)(cur.n0 + n2) * cur.K + cur.k0 + k8) = o;
    }
    if (!has) break;
    cur = nxt; it = nit;
#pragma unroll
    for (int i = 0; i < 8; ++i) v[i] = vn[i];
  }
  __syncthreads();
}

__device__ __forceinline__ void phase_modp(PP p, LAS unsigned char* lds) {
  LAS float* s = (LAS float*)lds;
  float* modp = (float*)(p->ws + WS_MODP);
  for (int it = blockIdx.x; it < 2 * 24 * 8; it += gridDim.x) {
    const int kc = it & 7, nc = (it >> 3) % 24, layer = it / 192;
    const int k0 = kc * 256;
    for (int idx = ltid(); idx < 17 * 256; idx += NTHR) {
      const int r = idx >> 8, k = idx & 255;
      const float v = r < 16 ? p->in[1][r * D + k0 + k] : p->in[3][k0 + k];
      s[idx] = v / (1.f + expf(-v));
    }
    __syncthreads();
    const int n = nc * 512 + ltid();
    const float* w = p->in[4] + (size_t)layer * D * NMOD + (size_t)k0 * NMOD + n;
    float acc[17];
#pragma unroll
    for (int r = 0; r < 17; ++r) acc[r] = 0.f;
    for (int k4 = 0; k4 < 64; ++k4) {
      const float w0 = w[(size_t)(4 * k4) * NMOD], w1 = w[(size_t)(4 * k4 + 1) * NMOD], w2 = w[(size_t)(4 * k4 + 2) * NMOD], w3 = w[(size_t)(4 * k4 + 3) * NMOD];
#pragma unroll
      for (int r = 0; r < 17; ++r) {
        const f32x4 sv = *(const LAS f32x4*)(s + r * 256 + 4 * k4);
        acc[r] += sv[0] * w0 + sv[1] * w1 + sv[2] * w2 + sv[3] * w3;
      }
    }
#pragma unroll
    for (int r = 0; r < 17; ++r) modp[((size_t)(layer * 8 + kc) * 17 + r) * NMOD + n] = acc[r];
    __syncthreads();
  }
}

__device__ __forceinline__ void phase_filter(PP p, LAS unsigned char* lds) {
  LAS float* z = (LAS float*)lds;
  LAS float* h1 = z + 8 * 33;
  LAS float* h2 = h1 + 8 * 64;
  float* hft = (float*)(p->ws + WS_HFT);
  float* normp = (float*)(p->ws + WS_NORMP);
  for (int it = blockIdx.x; it < 2 * 288; it += gridDim.x) {
    const int layer = it / 288, ch = it % 288;
    const int stream = ch >= 256;
    const int L = stream ? LC : LS;
    const int l0 = (stream ? ch - 256 : ch) * 8;
    const int tid = ltid();
    const float* w1 = p->in[13] + layer * 33 * 64; const float* b1 = p->in[14] + layer * 64;
    const float* w2 = p->in[15] + layer * 64 * 64; const float* b2 = p->in[16] + layer * 64;
    const float* w3 = p->in[17] + (size_t)layer * 64 * 1024; const float* fq = p->in[18] + layer * 128;
    if (tid < 8 * 33) {
      const int pp = tid / 33, j = tid % 33;
      const int l = l0 + pp;
      const float t = (float)l / (float)(L - 1);
      const float w = (6.283185307179586f / (float)L) * (float)l;
      float v;
      if (j == 0) v = t;
      else {
        const int jj = (j - 1) & 15;
        const float f = 1e-4f + (float)jj * ((15.f - 1e-4f) / 15.f);
        v = j <= 16 ? cosf(f * w) : -sinf(f * w);
      }
      z[pp * 33 + j] = v;
    }
    __syncthreads();
    {
      const int pp = tid >> 6, o = tid & 63;
      float a = b1[o];
      for (int j = 0; j < 33; ++j) a += z[pp * 33 + j] * w1[j * 64 + o];
      h1[pp * 64 + o] = sinf(fq[o] * a);
    }
    __syncthreads();
    {
      const int pp = tid >> 6, o = tid & 63;
      float a = b2[o];
      for (int j = 0; j < 64; ++j) a += h1[pp * 64 + j] * w2[j * 64 + o];
      h2[pp * 64 + o] = sinf(fq[64 + o] * a);
    }
    __syncthreads();
    {
      const int c = tid;
      float a0[8], a1[8];
#pragma unroll
      for (int q = 0; q < 8; ++q) { a0[q] = 0.f; a1[q] = 0.f; }
      for (int o = 0; o < 64; ++o) {
        const float wa = w3[o * 1024 + c], wb = w3[o * 1024 + 512 + c];
#pragma unroll
        for (int q = 0; q < 8; ++q) { const float hv = h2[q * 64 + o]; a0[q] += hv * wa; a1[q] += hv * wb; }
      }
      const float da = logf(1e-2f) / 1.5f, db = logf(1e-2f) / 0.3f;
      const float delta = fabsf(da + (float)c * ((db - da) / 511.f));
      float asum = 0.f;
      const int loff = (stream ? LS : 0) + l0;
#pragma unroll
      for (int q = 0; q < 8; ++q) {
        const float t = (float)(l0 + q) / (float)(L - 1);
        const float dec = expf(-t * delta) + 0.05f;
        const float v0 = a0[q] * dec, v1 = a1[q] * dec;
        hft[((size_t)(layer * 2 + 0) * 512 + c) * LALL + loff + q] = v0;
        hft[((size_t)(layer * 2 + 1) * 512 + c) * LALL + loff + q] = v1;
        asum += fabsf(v0) + fabsf(v1);
      }
      normp[((size_t)layer * 288 + ch) * 512 + c] = asum;
    }
    __syncthreads();
  }
}

__device__ __forceinline__ void phase_fnmat(PP p, LAS unsigned char* lds) {
  LAS float* ct = (LAS float*)lds;
  bf16_t* csw = (bf16_t*)(p->ws + WS_CSW);
  __syncthreads();
  if (ltid() < 128) ct[ltid()] = cosf((float)ltid() * (6.283185307179586f / 128.f));
  __syncthreads();
  const long nth = (long)gridDim.x * NTHR, gt = (long)blockIdx.x * NTHR + ltid();
  for (long idx = gt; idx < (long)16 * 16384; idx += nth) {
    const int e = (int)(idx & 127), d = (int)((idx >> 7) & 127), it = (int)(idx >> 14);
    const int cs = it & 1, g = (it >> 1) & 3, layer = it >> 3;
    const float* w = p->in[20] + (size_t)(layer * 4 + g) * 128 * 128 + e;
    float a = 0.f;
#pragma unroll 8
    for (int d2 = 0; d2 < 128; ++d2) {
      const int m = (d * d2) & 127;
      a += ct[cs ? ((m - 32) & 127) : m] * w[d2 * 128];
    }
    bf16_t* dst = csw + ((size_t)((layer * 4 + g) * 256 + cs * 128 + e)) * 256;
    dst[d] = f2bf(a * 0.08838834764831845f);
    dst[128 + d] = 0;
  }
  __syncthreads();
}

__device__ __forceinline__ void phase_dft(PP p) {
  {
    float* wcb = (float*)(p->ws + WS_WCB);
    const long nth0 = (long)gridDim.x * NTHR, gt0 = (long)blockIdx.x * NTHR + ltid();
    for (long idx = gt0; idx < (long)2 * DFF * 8; idx += nth0) {
      const int q = (int)(idx & 7), jc = (int)((idx >> 3) % DFF), layer = (int)(idx / (8 * DFF));
      const int col = (q >> 2) * DFF + jc;
      wcb[idx] = (q & 3) == 0 ? p->in[28][(size_t)layer * DFF2 + col] : p->in[27][((size_t)layer * 3 + ((q & 3) - 1)) * DFF2 + col];
    }
  }
  bf16_t* dft = (bf16_t*)(p->ws + WS_DFT);
  bf16_t* dftc = (bf16_t*)(p->ws + WS_DFTC);
  const long nth = (long)gridDim.x * NTHR, gt = (long)blockIdx.x * NTHR + ltid();
  for (long idx = gt; idx < (long)2048 * 4096 / 8; idx += nth) {
    const int l = (int)(idx / 512), j0 = (int)(idx % 512) * 8;
    u32x4 pk;
#pragma unroll
    for (int q = 0; q < 4; ++q) {
      float v[2];
#pragma unroll
      for (int e = 0; e < 2; ++e) {
        const int j = j0 + q * 2 + e; const int cs = j >> 11, l2 = j & 2047;
        const int m = (l * l2) & 2047;
        const float ang = (float)m * (6.283185307179586f / 2048.f);
        v[e] = (cs ? -sinf(ang) : cosf(ang)) * 0.022097086912079608f;
      }
      pk[q] = pk2(v[0], v[1]);
    }
    *(u32x4*)(dft + (size_t)l * 4096 + j0) = pk;
  }
  for (long idx = gt; idx < (long)256 * 512 / 8; idx += nth) {
    const int l = (int)(idx / 64), j0 = (int)(idx % 64) * 8;
    u32x4 pk;
#pragma unroll
    for (int q = 0; q < 4; ++q) {
      float v[2];
#pragma unroll
      for (int e = 0; e < 2; ++e) {
        const int j = j0 + q * 2 + e; const int cs = j >> 8, l2 = j & 255;
        const int m = (l * l2) & 255;
        const float ang = (float)m * (6.283185307179586f / 256.f);
        v[e] = (cs ? -sinf(ang) : cosf(ang)) * 0.0625f;
      }
      pk[q] = pk2(v[0], v[1]);
    }
    *(u32x4*)(dftc + (size_t)l * 512 + j0) = pk;
  }
}

__device__ __forceinline__ void phase_reduce(PP p) {
  const float* modp = (const float*)(p->ws + WS_MODP);
  float* mod = (float*)(p->ws + WS_MOD);
  const long nth = (long)gridDim.x * NTHR, gt = (long)blockIdx.x * NTHR + ltid();
  for (long idx = gt; idx < (long)2 * 17 * NMOD; idx += nth) {
    const int n = (int)(idx % NMOD), r = (int)((idx / NMOD) % 17), layer = (int)(idx / (17 * NMOD));
    float a = p->in[5][layer * NMOD + n];
#pragma unroll
    for (int kc = 0; kc < 8; ++kc) a += modp[((size_t)(layer * 8 + kc) * 17 + r) * NMOD + n];
    mod[idx] = a;
  }
  const float* normp = (const float*)(p->ws + WS_NORMP);
  float* hnorm = (float*)(p->ws + WS_HNORM);
  for (long idx = gt; idx < 2 * 2 * 512; idx += nth) {
    const int c = (int)(idx & 511), stream = (int)((idx >> 9) & 1), layer = (int)(idx >> 10);
    const int c0 = stream ? 256 : 0, c1 = stream ? 288 : 256;
    float a = 0.f;
    for (int ch = c0; ch < c1; ++ch) a += normp[((size_t)layer * 288 + ch) * 512 + c];
    hnorm[idx] = 1.f / (a + EPSF);
  }
}

__device__ __forceinline__ void phase_norm(PP p, int layer, int which, int nrows) {
  const int lane = ltid() & 63;
  const int gw = blockIdx.x * (NTHR / 64) + (ltid() >> 6), nw = gridDim.x * (NTHR / 64);
  const float* mod = (const float*)(p->ws + WS_MOD) + (size_t)layer * 17 * NMOD;
  const float* gain = (which ? p->in[25] : p->in[6]) + layer * D;
  bf16_t* H = (bf16_t*)(p->ws + WS_HY);
  const bool first = (layer == 0 && which == 0);
  for (int row = gw; row < nrows; row += nw) {
    const float* src = first ? (row < NLAT ? p->in[0] + (size_t)row * D : p->in[2] + (size_t)(row - NLAT) * D)
                             : (row < NLAT ? p->out + (size_t)row * D : (const float*)(p->ws + WS_CX) + (size_t)(row - NLAT) * D);
    float* dstx = row < NLAT ? p->out + (size_t)row * D : (float*)(p->ws + WS_CX) + (size_t)(row - NLAT) * D;
    f32x4 v[8];
    float ss = 0.f;
#pragma unroll
    for (int i = 0; i < 8; ++i) { v[i] = *(const f32x4*)(src + i * 256 + lane * 4); ss += v[i][0] * v[i][0] + v[i][1] * v[i][1] + v[i][2] * v[i][2] + v[i][3] * v[i][3]; }
    ss = wave_sum(ss);
    const float rinv = rsqrtf(ss * (1.f / D) + EPSF);
    const int mb = row < NLAT ? (row >> 11) : 16;
    const float* sh = mod + (size_t)mb * NMOD + (which ? 3 : 0) * D;
    const float* sc = mod + (size_t)mb * NMOD + (which ? 4 : 1) * D;
#pragma unroll
    for (int i = 0; i < 8; ++i) {
      const int c = i * 256 + lane * 4;
      const f32x4 g = *(const f32x4*)(gain + c), s1 = *(const f32x4*)(sc + c), s0 = *(const f32x4*)(sh + c);
      f32x4 h;
#pragma unroll
      for (int e = 0; e < 4; ++e) h[e] = (v[i][e] * rinv * g[e]) * (1.f + s1[e]) + s0[e];
      u32x2 pk; pk[0] = pk2(h[0], h[1]); pk[1] = pk2(h[2], h[3]);
      *(u32x2*)(H + (size_t)row * D + c) = pk;
      if (first) *(f32x4*)(dstx + c) = v[i];
    }
  }
}

__device__ __forceinline__ void item_hyprep_vt(PP p, int layer, int stream, int b, int tch, LAS unsigned char* lds) {
  LAS bf16_t* tl = (LAS bf16_t*)lds;
  const bf16_t* proj = (const bf16_t*)(p->ws + WS_PROJ);
  const int L = stream ? LC : LS;
  const int rowbase = stream ? NLAT + b * LC : b * LS;
  const int posbase = stream ? LS : 0;
  const int t0 = tch * 64, tid = ltid();
  const float* cw = p->in[11] + (size_t)layer * 3 * 1536; const float* cb = p->in[12] + layer * 1536;
  bf16_t* st = (bf16_t*)(p->ws + WS_ST);
  bf16_t* vt = (bf16_t*)(p->ws + WS_VT);
  __syncthreads();
#pragma unroll 2
  for (int i = 0; i < 8; ++i) {
    const int task = tid + 512 * i; const int tt = task >> 6, c0 = (task & 63) * 8;
    const int t = t0 + tt;
    const u32x4 zz = {0u, 0u, 0u, 0u};
    const bf16_t* rp = proj + (size_t)(rowbase + t) * NP + C_HY + 512 + c0;
    const u32x4 x1m = t > 0 ? *(const u32x4*)(rp - NP) : zz, x1c = *(const u32x4*)rp, x1p = t + 1 < L ? *(const u32x4*)(rp + NP) : zz;
    const u32x4 vm = t > 0 ? *(const u32x4*)(rp + 512 - NP) : zz, vc = *(const u32x4*)(rp + 512), vp = t + 1 < L ? *(const u32x4*)(rp + 512 + NP) : zz;
#pragma unroll
    for (int q = 0; q < 4; ++q)
#pragma unroll
      for (int e = 0; e < 2; ++e) {
        const int j1 = 512 + c0 + 2 * q + e, j2 = 1024 + c0 + 2 * q + e;
        const float u1 = cb[j1] + cw[j1] * (e ? hi_bf(x1m[q]) : lo_bf(x1m[q])) + cw[1536 + j1] * (e ? hi_bf(x1c[q]) : lo_bf(x1c[q])) + cw[3072 + j1] * (e ? hi_bf(x1p[q]) : lo_bf(x1p[q]));
        const float u2 = cb[j2] + cw[j2] * (e ? hi_bf(vm[q]) : lo_bf(vm[q])) + cw[1536 + j2] * (e ? hi_bf(vc[q]) : lo_bf(vc[q])) + cw[3072 + j2] * (e ? hi_bf(vp[q]) : lo_bf(vp[q]));
        tl[(c0 + 2 * q + e) * 72 + tt] = f2bf(u1 * u2);
      }
  }
  __syncthreads();
#pragma unroll
  for (int i = 0; i < 8; ++i) {
    const int pc_ = tid + 512 * i; const int c = pc_ >> 3, p8 = (pc_ & 7) * 8;
    *(u32x4*)(st + ((size_t)c * 16 + b) * LALL + posbase + t0 + p8) = *(const LAS u32x4*)(tl + c * 72 + p8);
  }
  __syncthreads();
#pragma unroll 4
  for (int i = 0; i < 8; ++i) {
    const int task = tid + 512 * i; const int tt = task >> 6, c0 = (task & 63) * 8;
    const u32x4 v = *(const u32x4*)(proj + (size_t)(rowbase + t0 + tt) * NP + C_NV + c0);
#pragma unroll
    for (int q = 0; q < 4; ++q) { tl[(c0 + 2 * q) * 72 + tt] = (bf16_t)(v[q] & 0xffffu); tl[(c0 + 2 * q + 1) * 72 + tt] = (bf16_t)(v[q] >> 16); }
  }
  __syncthreads();
#pragma unroll
  for (int i = 0; i < 8; ++i) {
    const int pc_ = tid + 512 * i; const int c = pc_ >> 3, p8 = (pc_ & 7) * 8;
    *(u32x4*)(vt + ((size_t)b * 512 + c) * LALL + posbase + t0 + p8) = *(const LAS u32x4*)(tl + c * 72 + p8);
  }
}

__device__ __forceinline__ void phase_qknorm(PP p, int layer, int bc, int bG) {
  const bf16_t* proj = (const bf16_t*)(p->ws + WS_PROJ);
  bf16_t* qn = (bf16_t*)(p->ws + WS_QN); bf16_t* kn = (bf16_t*)(p->ws + WS_KN);
  const int lane = ltid() & 63;
  const int gw = bc * (NTHR / 64) + (ltid() >> 6), nw = bG * (NTHR / 64);
  const float* gq = p->in[21] + layer * 128; const float* gk = p->in[22] + layer * 128;
  const int d0 = (lane & 15) * 8;
  float gqv[8], gkv[8];
#pragma unroll
  for (int e = 0; e < 8; ++e) { gqv[e] = gq[d0 + e]; gkv[e] = gk[d0 + e]; }
  for (int row = gw; row < NTOK; row += nw) {
    const int b = row < NLAT ? (row >> 11) : ((row - NLAT) >> 8);
    const int pos = row < NLAT ? (row & 2047) : LS + ((row - NLAT) & 255);
    const u32x4 qv = *(const u32x4*)(proj + (size_t)row * NP + C_NQ + lane * 8);
    const u32x4 kv = *(const u32x4*)(proj + (size_t)row * NP + C_NK + lane * 8);
    float qf[8], kf[8]; float sq = 0.f, sk = 0.f;
#pragma unroll
    for (int e = 0; e < 4; ++e) { qf[2 * e] = lo_bf(qv[e]); qf[2 * e + 1] = hi_bf(qv[e]); kf[2 * e] = lo_bf(kv[e]); kf[2 * e + 1] = hi_bf(kv[e]); }
#pragma unroll
    for (int e = 0; e < 8; ++e) { sq += qf[e] * qf[e]; sk += kf[e] * kf[e]; }
#pragma unroll
    for (int m = 8; m >= 1; m >>= 1) { sq += shfl_xor_l(sq, m); sk += shfl_xor_l(sk, m); }
    const float rq = rsqrtf(sq * (1.f / 128.f) + EPSF) * 0.08838834764831845f, rk = rsqrtf(sk * (1.f / 128.f) + EPSF);
    u32x4 oq, ok;
#pragma unroll
    for (int e = 0; e < 4; ++e) {
      oq[e] = pk2(qf[2 * e] * rq * gqv[2 * e], qf[2 * e + 1] * rq * gqv[2 * e + 1]);
      ok[e] = pk2(kf[2 * e] * rk * gkv[2 * e], kf[2 * e + 1] * rk * gkv[2 * e + 1]);
    }
    const size_t o = ((size_t)b * LALL + pos) * 512 + lane * 8;
    *(u32x4*)(qn + o) = oq; *(u32x4*)(kn + o) = ok;
  }
}

template <int STREAM>
__device__ __forceinline__ void item_hyena(PP p, int layer, int cg4, int tr, LAS unsigned char* lds) {
  constexpr int L = STREAM ? LC : LS;
  constexpr int TL = STREAM ? 520 : 2312;
  constexpr int NK = STREAM ? 1 : 8;
  constexpr int SBS = 2056;
  constexpr int posbase = STREAM ? LS : 0;
  const int T0 = tr * 256;
  const int base = L - 256 - T0;
  LAS bf16_t* tab = (LAS bf16_t*)lds;
  LAS bf16_t* sB = (LAS bf16_t*)(lds + 36992);
  LAS bf16_t* outs = (LAS bf16_t*)(lds + 102784);
  LAS float* gl = (LAS float*)(lds + 135552);
  LAS int* outi = (LAS int*)(lds + 144800);
  const float* hft = (const float*)(p->ws + WS_HFT);
  const float* hnorm = (const float*)(p->ws + WS_HNORM);
  const bf16_t* st = (const bf16_t*)(p->ws + WS_ST);
  const float* hbias_ = p->in[19] + layer * 512;
  const int tid = ltid(), wid = tid >> 6, lane = tid & 63, fr = lane & 15, fq = lane >> 4;
  constexpr int ngl = STREAM ? 1 : 5, nb = STREAM ? 1 : 8;
  constexpr int cshift = STREAM ? 5 : 8;
  float glr[ngl]; u32x4 br[nb];
#define HY_LOAD(ch_) do { const int c_ = cg4 * 4 + (ch_); const float inv_ = hnorm[(layer * 2 + STREAM) * 512 + c_]; \
    const float* hf0_ = hft + ((size_t)(layer * 2 + 0) * 512 + c_) * LALL + posbase; const float* hf1_ = hft + ((size_t)(layer * 2 + 1) * 512 + c_) * LALL + posbase; \
    _Pragma("unroll") for (int i = 0; i < ngl; ++i) { const int j = tid + 512 * i; float v = 0.f; \
      if (j < 255 + L) { const int dd = L - 1 - (base + j); v = dd > 0 ? hf0_[dd] * inv_ : (dd < 0 ? hf1_[-dd] * inv_ : (hf0_[0] + hf1_[0]) * inv_ + hbias_[c_]); } glr[i] = v; } \
    _Pragma("unroll") for (int i = 0; i < nb; ++i) { const int idx = tid + 512 * i; const int b_ = idx >> cshift, c8_ = idx & ((1 << cshift) - 1); \
      br[i] = *(const u32x4*)(st + ((size_t)c_ * 16 + b_) * LALL + posbase + c8_ * 8); } } while (0)
  HY_LOAD(0);
#pragma unroll
  for (int i = 0; i < 8; ++i) outi[tid + 512 * i] = 0;
  for (int ch = 0; ch < 4; ++ch) {
    LBAR();
#pragma unroll
    for (int i = 0; i < ngl; ++i) {
      const int j = tid + 512 * i;
      if (j < 255 + L) {
        const bf16_t v = f2bf(glr[i]);
#pragma unroll
        for (int r = 0; r < 8; ++r) if (j - r >= 0) tab[r * TL + j - r] = v;
      }
    }
#pragma unroll
    for (int i = 0; i < nb; ++i) { const int idx = tid + 512 * i; const int b_ = idx >> cshift, c8_ = idx & ((1 << cshift) - 1); *(LAS u32x4*)(sB + b_ * SBS + c8_ * 8) = br[i]; }
    if (ch + 1 < 4) HY_LOAD(ch + 1);
    LBAR();
    {
      const int r = 7 - (fr & 7);
      const int Sw = 32 * NK * wid;
      const LAS bf16_t* tb = tab + r * TL + (255 - fr - r) + 8 * fq + Sw;
      bf16x8 Bf[NK];
#pragma unroll
      for (int k = 0; k < NK; ++k) Bf[k] = *(const LAS bf16x8*)(sB + fr * SBS + 8 * fq + Sw + 32 * k);
      f32x4 acc[16];
#pragma unroll
      for (int mt = 0; mt < 16; ++mt) acc[mt] = (f32x4){0.f, 0.f, 0.f, 0.f};
#pragma unroll
      for (int q = -15; q <= 2 * (NK - 1); ++q) {
        const bf16x8 af = *(const LAS bf16x8*)(tb + 16 * q);
#pragma unroll
        for (int k = 0; k < NK; ++k) {
          const int mt = 2 * k - q;
          if (mt >= 0 && mt < 16) acc[mt] = __builtin_amdgcn_mfma_f32_16x16x32_bf16(af, Bf[k], acc[mt], 0, 0, 0);
        }
      }
#pragma unroll
      for (int mt = 0; mt < 16; ++mt)
#pragma unroll
        for (int j = 0; j < 4; ++j) __hip_atomic_fetch_add(outi + (16 * mt + 4 * fq + j) * 16 + fr, __float2int_rn(acc[mt][j] * 1048576.f), __ATOMIC_RELAXED, __HIP_MEMORY_SCOPE_WORKGROUP);
    }
    LBAR();
#pragma unroll
    for (int i = 0; i < 8; ++i) { const int idx = tid + 512 * i; outs[idx * 4 + ch] = f2bf((float)outi[idx] * (1.f / 1048576.f)); outi[idx] = 0; }
  }
#undef HY_LOAD
  LBAR();
  bf16_t* proj = (bf16_t*)(p->ws + WS_PROJ);
  const int c0 = cg4 * 4;
#pragma unroll
  for (int i = 0; i < 8; ++i) {
    const int pi = tid + 512 * i;
    const int tl = pi >> 4, b = pi & 15;
    const int row = (STREAM ? NLAT + b * LC : b * LS) + T0 + tl;
    *(u32x2*)(proj + (size_t)row * NP + C_HY + 512 + c0) = *(const LAS u32x2*)(outs + (size_t)pi * 4);
  }
  LBAR();
}

__device__ __forceinline__ void phase_hy_fin(PP p, int layer, int nrows) {
  const bf16_t* proj = (const bf16_t*)(p->ws + WS_PROJ);
  bf16_t* Y = (bf16_t*)(p->ws + WS_HY);
  const float* cw = p->in[11] + (size_t)layer * 3 * 1536; const float* cb = p->in[12] + layer * 1536;
  const long nth = (long)gridDim.x * NTHR, gt = (long)blockIdx.x * NTHR + ltid();
  for (long idx = gt; idx < (long)nrows * 64; idx += nth) {
    const int c0 = (int)(idx & 63) * 8; const int row = (int)(idx >> 6);
    const int L = row < NLAT ? LS : LC;
    const int t = row < NLAT ? (row & 2047) : ((row - NLAT) & 255);
    const u32x4 zz = {0u, 0u, 0u, 0u};
    const bf16_t* rp = proj + (size_t)row * NP + C_HY + c0;
    const u32x4 xm = t > 0 ? *(const u32x4*)(rp - NP) : zz, x0 = *(const u32x4*)rp, xp = t + 1 < L ? *(const u32x4*)(rp + NP) : zz;
    const u32x4 cv = *(const u32x4*)(rp + 512);
    u32x4 pk;
#pragma unroll
    for (int q = 0; q < 4; ++q) {
      float y[2];
#pragma unroll
      for (int e = 0; e < 2; ++e) {
        const int c = c0 + q * 2 + e;
        const float u0 = cb[c] + cw[c] * (e ? hi_bf(xm[q]) : lo_bf(xm[q])) + cw[1536 + c] * (e ? hi_bf(x0[q]) : lo_bf(x0[q])) + cw[3072 + c] * (e ? hi_bf(xp[q]) : lo_bf(xp[q]));
        y[e] = (e ? hi_bf(cv[q]) : lo_bf(cv[q])) * u0;
      }
      pk[q] = pk2(y[0], y[1]);
    }
    *(u32x4*)(Y + (size_t)row * D + 512 + c0) = pk;
  }
}

constexpr int NA_KS = 136, NA_VS = 72;
__device__ __forceinline__ void na_pair(const LAS bf16_t* kb, const LAS bf16_t* vb, const bf16x8 (&qf)[4], f32x4 (&o)[8], float& lsum,
                                        bool local, int kcb, int krow, int r, int qc, int col0, int fq, const LAS float* rpb) {
  f32x4 s0 = {0.f, 0.f, 0.f, 0.f}, s1 = {0.f, 0.f, 0.f, 0.f};
#pragma unroll
  for (int ks = 0; ks < 4; ++ks) {
    const bf16x8 k0 = *(const LAS bf16x8*)(kb + 32 * ks), k1 = *(const LAS bf16x8*)(kb + 16 * NA_KS + 32 * ks);
    s0 = __builtin_amdgcn_mfma_f32_16x16x32_bf16(k0, qf[ks], s0, 0, 0, 0);
    s1 = __builtin_amdgcn_mfma_f32_16x16x32_bf16(k1, qf[ks], s1, 0, 0, 0);
  }
  float pv[8];
#pragma unroll
  for (int j = 0; j < 8; ++j) {
    const float sv = j < 4 ? s0[j] : s1[j - 4];
    float pe;
    if (local) {
      const int kc = kcb + (j < 4 ? 0 : 16) + 4 * fq + (j & 3);
      const bool inw = (kc >= col0) && (kc < col0 + 16);
      const int dr = krow - r + 7;
      const int dc = min(max(kc - qc + 15, 0), 30);
      pe = inw ? __expf(sv + rpb[dr * 31 + dc]) : 0.f;
    } else pe = __expf(sv);
    pv[j] = pe; lsum += pe;
  }
  bf16x8 pf;
  {
    u32x4 t; t[0] = pk2(pv[0], pv[1]); t[1] = pk2(pv[2], pv[3]); t[2] = pk2(pv[4], pv[5]); t[3] = pk2(pv[6], pv[7]);
    pf = __builtin_bit_cast(bf16x8, t);
  }
#pragma unroll
  for (int dt = 0; dt < 8; ++dt) {
    const u32x2 va = *(const LAS u32x2*)(vb + 16 * dt * NA_VS), vbb = *(const LAS u32x2*)(vb + 16 * dt * NA_VS + 16);
    u32x4 t; t[0] = va[0]; t[1] = va[1]; t[2] = vbb[0]; t[3] = vbb[1];
    o[dt] = __builtin_amdgcn_mfma_f32_16x16x32_bf16(__builtin_bit_cast(bf16x8, t), pf, o[dt], 0, 0, 0);
  }
}

__device__ __forceinline__ void item_natten(PP p, int layer, int b, int h, int rp, bool isctx, LAS unsigned char* lds) {
  const LAS float* rpb = (const LAS float*)lds;
  LAS bf16_t* Kt = (LAS bf16_t*)(lds + 2048);
  LAS bf16_t* Vtt = Kt + 3 * 64 * NA_KS;
  const bf16_t* qn = (const bf16_t*)(p->ws + WS_QN) + (size_t)b * LALL * 512 + h * 128;
  const bf16_t* kn = (const bf16_t*)(p->ws + WS_KN) + (size_t)b * LALL * 512 + h * 128;
  const bf16_t* vt = (const bf16_t*)(p->ws + WS_VT) + ((size_t)b * 512 + h * 128) * LALL;
  const int tid = ltid(), wid = tid >> 6, lane = tid & 63, fr = lane & 15, fq = lane >> 4;
  const int r = isctx ? 0 : 2 * rp + (wid >> 2);
  const int qt = isctx ? rp * 8 + wid : (wid & 3);
  const int qpos = isctx ? LS + 16 * qt + fr : r * 64 + 16 * qt + fr;
  bf16x8 qf[4];
#pragma unroll
  for (int ks = 0; ks < 4; ++ks) qf[ks] = *(const bf16x8*)(qn + (size_t)qpos * 512 + 32 * ks + 8 * fq);
  f32x4 o[8];
#pragma unroll
  for (int dt = 0; dt < 8; ++dt) o[dt] = (f32x4){0.f, 0.f, 0.f, 0.f};
  float lsum = 0.f;
  const int qc = 16 * qt + fr;
  const int col0 = min(max(qc - 8, 0), 48);
  const int kr0 = min(max(r - 4, 0), 24);
  const int kr_lo = min(max(2 * rp - 4, 0), 24), kr_hi = min(max(2 * rp - 3, 0), 24) + 7;
  const int nloc = isctx ? 0 : (kr_hi - kr_lo + 1);
  const int nstage = nloc + 4;
  const int lkey = tid >> 4, lkp = tid & 15, ldd = tid >> 2, lvp = tid & 3;
#define NA_P0(j_) ((j_) < nloc ? (kr_lo + (j_)) * 64 : LS + 64 * ((j_) - nloc))
#define NA_LOAD(S_, P0_) do { S_##k0 = *(const u32x4*)(kn + (size_t)((P0_) + lkey) * 512 + lkp * 8); S_##k1 = *(const u32x4*)(kn + (size_t)((P0_) + 32 + lkey) * 512 + lkp * 8); \
    S_##v0 = *(const u32x4*)(vt + (size_t)ldd * LALL + (P0_) + lvp * 8); S_##v1 = *(const u32x4*)(vt + (size_t)ldd * LALL + (P0_) + 32 + lvp * 8); } while (0)
#define NA_STORE(S_, buf_) do { LAS bf16_t* kd_ = Kt + (buf_) * 64 * NA_KS; LAS bf16_t* vd_ = Vtt + (buf_) * 128 * NA_VS; \
    *(LAS u32x4*)(kd_ + lkey * NA_KS + lkp * 8) = S_##k0; *(LAS u32x4*)(kd_ + (32 + lkey) * NA_KS + lkp * 8) = S_##k1; \
    *(LAS u32x4*)(vd_ + ldd * NA_VS + lvp * 8) = S_##v0; *(LAS u32x4*)(vd_ + ldd * NA_VS + 32 + lvp * 8) = S_##v1; } while (0)
  u32x4 Ak0, Ak1, Av0, Av1, Bk0, Bk1, Bv0, Bv1;
  { const int P0 = NA_P0(0); NA_LOAD(A, P0); }
  LBAR();
  NA_STORE(A, 0);
  if (nstage > 1) { const int P1 = NA_P0(1); NA_LOAD(B, P1); }
  LBAR();
#define NA_BODY(it_, X_, Y_) do { const int it = (it_); \
    const int P0 = NA_P0(it); const bool local = it < nloc; const int bufc = it % 3; \
    if (it + 2 < nstage) { const int P2 = NA_P0(it + 2); NA_LOAD(X_, P2); } \
    const int krow = P0 >> 6; \
    const bool rowrel = !local || (krow >= kr0 && krow < kr0 + 8); \
    _Pragma("unroll") for (int pr = 0; pr < 2; ++pr) { \
      const int kcb = 32 * pr; \
      const bool rel = rowrel && !(local && ((qt == 0 && pr == 1) || (qt == 3 && pr == 0))); \
      if (rel) na_pair(Kt + bufc * 64 * NA_KS + (kcb + fr) * NA_KS + 8 * fq, Vtt + bufc * 128 * NA_VS + fr * NA_VS + kcb + 4 * fq, qf, o, lsum, local, kcb, krow, r, qc, col0, fq, rpb); \
    } \
    if (it + 1 < nstage) NA_STORE(Y_, (it + 1) % 3); \
    LBAR(); } while (0)
  for (int it2 = 0; it2 < nstage; it2 += 2) {
    NA_BODY(it2, A, B);
    if (it2 + 1 < nstage) NA_BODY(it2 + 1, B, A);
  }
#undef NA_BODY
#undef NA_P0
#undef NA_LOAD
#undef NA_STORE
  lsum += shfl_xor_l(lsum, 16); lsum += shfl_xor_l(lsum, 32);
  const float il = 1.f / lsum;
  bf16_t* Y = (bf16_t*)(p->ws + WS_HY);
  const int row = isctx ? NLAT + b * LC + 16 * qt + fr : b * LS + r * 64 + 16 * qt + fr;
#pragma unroll
  for (int dt = 0; dt < 8; ++dt) {
    u32x2 pk; pk[0] = pk2(o[dt][0] * il, o[dt][1] * il); pk[1] = pk2(o[dt][2] * il, o[dt][3] * il);
    *(u32x2*)(Y + (size_t)row * D + 1536 + h * 128 + 16 * dt + 4 * fq) = pk;
  }
}

constexpr int GS = 72;
constexpr int QS = 68;
constexpr int OS = 136;
#define GLA_BAR() asm volatile("s_waitcnt lgkmcnt(0)\n\ts_barrier" ::: "memory")
__device__ __forceinline__ void gla_sweep(PP p, int layer, int b, int h, int dir, LAS unsigned char* lds, int variant = 0) {
  LAS bf16_t* Qd = (LAS bf16_t*)lds;
  LAS bf16_t* Ki = Qd + 64 * GS;
  LAS bf16_t* KeT = Ki + 64 * GS;
  LAS bf16_t* Pm = KeT + 64 * GS;
  LAS bf16_t* Vt = Pm + 64 * GS;
  LAS bf16_t* St = Vt + 128 * GS;
  LAS float* segs = (LAS float*)(St + 128 * GS);
  LAS float* decay = segs + 512;
  LAS float* zf = decay + 64;
  LAS float* Qraw = zf + 1024;
  LAS float* Kraw = Qraw + 64 * QS;
  LAS float* crow = Kraw + 64 * QS;
  LAS float* srow = crow + 512;
  LAS bf16_t* Ot = (LAS bf16_t*)(srow + 512);
  const bf16_t* proj = (const bf16_t*)(p->ws + WS_PROJ);
  bf16_t* obuf = (bf16_t*)(p->ws + (variant ? WS_UT : WS_OGLA)) + (size_t)dir * NTOK * 512;
  const int tid = ltid(), wid = tid >> 6, lane = tid & 63, fr = lane & 15, fq = lane >> 4;
  const int dk = tid & 63, seg = tid >> 6;
  const int lpos = tid >> 3, lg = tid & 7;
  float wg[16];
  {
    const float* gw = p->in[8] + (size_t)((layer * 2 + dir) * 16) * 256 + h * 64 + dk;
#pragma unroll
    for (int r = 0; r < 16; ++r) wg[r] = gw[r * 256];
  }
  const float bg = p->in[9][(layer * 2 + dir) * 256 + h * 64 + dk];
  const float inv = powf(10000.f, -(float)(dk & 15) / 16.f);
  const int which = dk >> 5; const bool first = (dk & 31) < 16; const int partner = dk ^ 16;
  float cs8[8], sn8[8];
#pragma unroll
  for (int i = 0; i < 8; ++i) sincosf((float)(8 * seg + i) * inv, &sn8[i], &cs8[i]);
  f32x4 S[4];
#pragma unroll
  for (int i = 0; i < 4; ++i) S[i] = (f32x4){0.f, 0.f, 0.f, 0.f};
  GLA_BAR();
  { const int rr = tid >> 4, ff = tid & 15; float sn_, cs_; sincosf((float)rr * powf(10000.f, -(float)ff / 16.f), &sn_, &cs_); crow[tid] = cs_; srow[tid] = sn_; }
#pragma unroll
  for (int dkt = 0; dkt < 4; ++dkt) { u32x2 zz = {0u, 0u}; *(LAS u32x2*)(St + (16 * wid + fr) * GS + 16 * dkt + 4 * fq) = zz; }
  u32x4 rq, rk, rv0, rv1, rz;
#define GLA_ROW0(step_) (((step_) < 4) ? NLAT + b * LC + 64 * (dir == 0 ? (step_) : 3 - (step_)) : b * LS + 64 * (dir == 0 ? (step_) - 4 : 35 - (step_)))
#define GLA_LOAD(step_) do { const int r0_ = GLA_ROW0(step_); const bf16_t* rp_ = proj + (size_t)(r0_ + lpos) * NP; \
    rq = *(const u32x4*)(rp_ + C_GQ + h * 64 + lg * 8); rk = *(const u32x4*)(rp_ + C_GK + h * 64 + lg * 8); \
    { const bf16_t* vp_ = proj + (size_t)(r0_ + lane) * NP + C_GV + h * 128 + 16 * wid; rv0 = *(const u32x4*)vp_; rv1 = *(const u32x4*)(vp_ + 8); } \
    if (tid < 128) rz = *(const u32x4*)(proj + (size_t)(r0_ + (tid >> 1)) * NP + C_GZ + dir * 16 + (tid & 1) * 8); } while (0)
  GLA_LOAD(0);
  bool prev_o = false; int prev_row0 = 0;
  for (int step = 0; step < 36; ++step) {
    const bool isctx = step < 4;
    const int cidx = dir == 0 ? (isctx ? step : step - 4) : (isctx ? 3 - step : 35 - step);
    const int row0 = GLA_ROW0(step);
    const bool need_o = !(isctx && layer == 1);
    GLA_BAR();
    {
      f32x4 a, c2;
      a[0] = lo_bf(rq[0]); a[1] = hi_bf(rq[0]); a[2] = lo_bf(rq[1]); a[3] = hi_bf(rq[1]); c2[0] = lo_bf(rq[2]); c2[1] = hi_bf(rq[2]); c2[2] = lo_bf(rq[3]); c2[3] = hi_bf(rq[3]);
      *(LAS f32x4*)(Qraw + lpos * QS + lg * 8) = a; *(LAS f32x4*)(Qraw + lpos * QS + lg * 8 + 4) = c2;
      a[0] = lo_bf(rk[0]); a[1] = hi_bf(rk[0]); a[2] = lo_bf(rk[1]); a[3] = hi_bf(rk[1]); c2[0] = lo_bf(rk[2]); c2[1] = hi_bf(rk[2]); c2[2] = lo_bf(rk[3]); c2[3] = hi_bf(rk[3]);
      *(LAS f32x4*)(Kraw + lpos * QS + lg * 8) = a; *(LAS f32x4*)(Kraw + lpos * QS + lg * 8 + 4) = c2;
#pragma unroll
      for (int e = 0; e < 4; ++e) {
        Vt[(16 * wid + 2 * e) * GS + lane] = (bf16_t)(rv0[e] & 0xffffu); Vt[(16 * wid + 2 * e + 1) * GS + lane] = (bf16_t)(rv0[e] >> 16);
        Vt[(16 * wid + 8 + 2 * e) * GS + lane] = (bf16_t)(rv1[e] & 0xffffu); Vt[(16 * wid + 8 + 2 * e + 1) * GS + lane] = (bf16_t)(rv1[e] >> 16);
      }
      if (tid < 128) {
        a[0] = lo_bf(rz[0]); a[1] = hi_bf(rz[0]); a[2] = lo_bf(rz[1]); a[3] = hi_bf(rz[1]); c2[0] = lo_bf(rz[2]); c2[1] = hi_bf(rz[2]); c2[2] = lo_bf(rz[3]); c2[3] = hi_bf(rz[3]);
        *(LAS f32x4*)(zf + (tid >> 1) * 16 + (tid & 1) * 8) = a; *(LAS f32x4*)(zf + (tid >> 1) * 16 + (tid & 1) * 8 + 4) = c2;
      }
    }
    if (step > 0 && prev_o) {
#pragma unroll
      for (int i2 = 0; i2 < 2; ++i2) { const int pc_ = tid + 512 * i2; const int pr_ = pc_ >> 4, pp_ = pc_ & 15;
        *(u32x4*)(obuf + (size_t)(prev_row0 + pr_) * 512 + h * 128 + pp_ * 8) = *(const LAS u32x4*)(Ot + pr_ * OS + pp_ * 8); }
    }
    if (step + 1 < 36 && !(variant & 4)) GLA_LOAD(step + 1);
    GLA_BAR();
    prev_o = need_o && !(variant & 4); prev_row0 = row0;
    float cum[8]; float segtot = 0.f;
    if (variant & 2) { for (int i = 0; i < 8; ++i) cum[i] = -0.01f; } else
#pragma unroll
    for (int i = 0; i < 8; ++i) {
      const int pos = 8 * seg + i;
      float x = bg;
#pragma unroll
      for (int r = 0; r < 16; ++r) x += zf[pos * 16 + r] * wg[r];
      const float ls = fminf(x, 0.f) - __logf(1.f + __expf(-fabsf(x)));
      cum[i] = ls * (1.f / 16.f);
      segtot += cum[i];
    }
    if (dir == 0) {
#pragma unroll
      for (int i = 1; i < 8; ++i) cum[i] += cum[i - 1];
    } else {
#pragma unroll
      for (int i = 6; i >= 0; --i) cum[i] += cum[i + 1];
    }
    segs[seg * 64 + dk] = segtot;
    GLA_BAR();
    float offs = 0.f, total = 0.f;
#pragma unroll
    for (int s = 0; s < 8; ++s) { const float v = segs[s * 64 + dk]; total += v; if (dir == 0 ? (s < seg) : (s > seg)) offs += v; }
    if (seg == 0) decay[dk] = __expf(total);
    const float csr = crow[(isctx ? 0 : cidx) * 16 + (dk & 15)], snr = srow[(isctx ? 0 : cidx) * 16 + (dk & 15)];
    unsigned kev[4] = {0u, 0u, 0u, 0u};
    if (!(variant & 2))
#pragma unroll
    for (int i = 0; i < 8; ++i) {
      const int pos = 8 * seg + i;
      float q = Qraw[pos * QS + dk], k = Kraw[pos * QS + dk];
      if (!isctx) {
        const float qp = Qraw[pos * QS + partner], kp = Kraw[pos * QS + partner];
        const float cs = which ? cs8[i] : csr, sn = which ? sn8[i] : snr;
        q = first ? q * cs - qp * sn : qp * sn + q * cs;
        k = first ? k * cs - kp * sn : kp * sn + k * cs;
      }
      q *= 0.125f;
      const float c = cum[i] + offs;
      Qd[pos * GS + dk] = f2bf(q * __expf(c));
      Ki[pos * GS + dk] = f2bf(k * __expf(-c));
      { const unsigned kb_ = f2bf(k * __expf(total - c)); if (i & 1) kev[i >> 1] |= kb_ << 16; else kev[i >> 1] = kb_; }
    }
    { u32x4 kv4; kv4[0] = kev[0]; kv4[1] = kev[1]; kv4[2] = kev[2]; kv4[3] = kev[3]; *(LAS u32x4*)(KeT + dk * GS + 8 * seg) = kv4; }
    GLA_BAR();
    if (need_o && !(variant & 1)) {
      const int it = wid >> 1;
#pragma unroll
      for (int jj = 0; jj < 2; ++jj) {
        const int jt = (wid & 1) * 2 + jj;
        f32x4 acc = {0.f, 0.f, 0.f, 0.f};
#pragma unroll
        for (int ks = 0; ks < 2; ++ks) {
          const bf16x8 a = *(const LAS bf16x8*)(Qd + (16 * it + fr) * GS + 32 * ks + 8 * fq);
          const bf16x8 bb = *(const LAS bf16x8*)(Ki + (16 * jt + fr) * GS + 32 * ks + 8 * fq);
          acc = __builtin_amdgcn_mfma_f32_16x16x32_bf16(a, bb, acc, 0, 0, 0);
        }
#pragma unroll
        for (int j = 0; j < 4; ++j) {
          const int i = 16 * it + 4 * fq + j, jc = 16 * jt + fr;
          const bool keep = dir == 0 ? (jc <= i) : (jc >= i);
          Pm[i * GS + jc] = f2bf(keep ? acc[j] : 0.f);
        }
      }
    }
    GLA_BAR();
    if (need_o && !(variant & 1)) {
#pragma unroll
      for (int it2 = 0; it2 < 4; ++it2) {
        f32x4 acc = {0.f, 0.f, 0.f, 0.f};
#pragma unroll
        for (int ks = 0; ks < 2; ++ks) {
          const bf16x8 a = *(const LAS bf16x8*)(Pm + (16 * it2 + fr) * GS + 32 * ks + 8 * fq);
          const bf16x8 bb = *(const LAS bf16x8*)(Vt + (16 * wid + fr) * GS + 32 * ks + 8 * fq);
          acc = __builtin_amdgcn_mfma_f32_16x16x32_bf16(a, bb, acc, 0, 0, 0);
          const bf16x8 a2 = *(const LAS bf16x8*)(Qd + (16 * it2 + fr) * GS + 32 * ks + 8 * fq);
          const bf16x8 b2 = *(const LAS bf16x8*)(St + (16 * wid + fr) * GS + 32 * ks + 8 * fq);
          acc = __builtin_amdgcn_mfma_f32_16x16x32_bf16(a2, b2, acc, 0, 0, 0);
        }
#pragma unroll
        for (int j = 0; j < 4; ++j) Ot[(16 * it2 + 4 * fq + j) * OS + 16 * wid + fr] = f2bf(acc[j]);
      }
    }
    if (!(variant & 1))
#pragma unroll
    for (int dkt = 0; dkt < 4; ++dkt) {
      f32x4 s = S[dkt];
#pragma unroll
      for (int j = 0; j < 4; ++j) s[j] *= decay[16 * dkt + 4 * fq + j];
#pragma unroll
      for (int ks = 0; ks < 2; ++ks) {
        const bf16x8 a = *(const LAS bf16x8*)(KeT + (16 * dkt + fr) * GS + 32 * ks + 8 * fq);
        const bf16x8 bb = *(const LAS bf16x8*)(Vt + (16 * wid + fr) * GS + 32 * ks + 8 * fq);
        s = __builtin_amdgcn_mfma_f32_16x16x32_bf16(a, bb, s, 0, 0, 0);
      }
      S[dkt] = s;
      u32x2 pk; pk[0] = pk2(s[0], s[1]); pk[1] = pk2(s[2], s[3]);
      *(LAS u32x2*)(St + (16 * wid + fr) * GS + 16 * dkt + 4 * fq) = pk;
    }
  }
#undef GLA_LOAD
#undef GLA_ROW0
  GLA_BAR();
  if (prev_o) {
#pragma unroll
    for (int i2 = 0; i2 < 2; ++i2) { const int pc_ = tid + 512 * i2; const int pr_ = pc_ >> 4, pp_ = pc_ & 15;
      *(u32x4*)(obuf + (size_t)(prev_row0 + pr_) * 512 + h * 128 + pp_ * 8) = *(const LAS u32x4*)(Ot + pr_ * OS + pp_ * 8); }
  }
  GLA_BAR();
}

__device__ __forceinline__ void phase_gla_fin(PP p, int layer, int bc, int bG, int nrows) {
  const bf16_t* proj = (const bf16_t*)(p->ws + WS_PROJ);
  const bf16_t* of = (const bf16_t*)(p->ws + WS_OGLA);
  const bf16_t* ob = of + (size_t)NTOK * 512;
  bf16_t* Y = (bf16_t*)(p->ws + WS_HY);
  const int lane = ltid() & 63;
  const int gw = bc * (NTHR / 64) + (ltid() >> 6), nw = bG * (NTHR / 64);
  const float* gain = p->in[10] + layer * 128 + (lane & 15) * 8;
  float gv[8];
#pragma unroll
  for (int e = 0; e < 8; ++e) gv[e] = gain[e];
  for (int row = gw; row < nrows; row += nw) {
    const u32x4 a = *(const u32x4*)(of + (size_t)row * 512 + lane * 8), b2 = *(const u32x4*)(ob + (size_t)row * 512 + lane * 8);
    const u32x4 g = *(const u32x4*)(proj + (size_t)row * NP + C_GR + lane * 8);
    float o[8]; float ss = 0.f;
#pragma unroll
    for (int e = 0; e < 4; ++e) { o[2 * e] = lo_bf(a[e]) + lo_bf(b2[e]); o[2 * e + 1] = hi_bf(a[e]) + hi_bf(b2[e]); }
#pragma unroll
    for (int e = 0; e < 8; ++e) ss += o[e] * o[e];
#pragma unroll
    for (int m = 8; m >= 1; m >>= 1) ss += shfl_xor_l(ss, m);
    const float rinv = rsqrtf(ss * (1.f / 128.f) + EPSF);
    u32x4 pk;
#pragma unroll
    for (int e = 0; e < 4; ++e)
      pk[e] = pk2(o[2 * e] * rinv * gv[2 * e] * siluf(lo_bf(g[e])), o[2 * e + 1] * rinv * gv[2 * e + 1] * siluf(hi_bf(g[e])));
    *(u32x4*)(Y + (size_t)row * D + lane * 8) = pk;
  }
}

__device__ __forceinline__ void phase_ffn_edge(PP p, int layer, int ntiles) {
  const float* EDGE = (const float*)(p->ws + WS_EDGE);
  bf16_t* ACT = (bf16_t*)(p->ws + WS_ACT);
  const float* cw = p->in[27] + (size_t)layer * 3 * DFF2; const float* cb = p->in[28] + (size_t)layer * DFF2;
  const long nth = (long)gridDim.x * NTHR, gt = (long)blockIdx.x * NTHR + ltid();
  const long nitems = (long)ntiles * 2 * (DFF / 4);
  for (long idx = gt; idx < nitems; idx += nth) {
    const int j = (int)(idx % (DFF / 4)) * 4; const int tb = (int)((idx / (DFF / 4)) & 1); const int tm = (int)(idx / (DFF / 2));
    const bool seq_start = tm >= 128 || (tm & 7) == 0, seq_end = tm >= 128 || (tm & 7) == 7;
    const f32x4 zz = {0.f, 0.f, 0.f, 0.f};
    f32x4 v[2][3];
#pragma unroll
    for (int bj = 0; bj < 2; ++bj) {
      const float* e0 = EDGE + ((size_t)(tm * 4) * 2 + bj) * DFF + j;
      if (tb == 0) {
        v[bj][0] = seq_start ? zz : *(const f32x4*)(e0 - (size_t)2 * DFF);
        v[bj][1] = *(const f32x4*)e0;
        v[bj][2] = *(const f32x4*)(e0 + (size_t)2 * DFF);
      } else {
        v[bj][0] = *(const f32x4*)(e0 + (size_t)4 * DFF);
        v[bj][1] = *(const f32x4*)(e0 + (size_t)6 * DFF);
        v[bj][2] = seq_end ? zz : *(const f32x4*)(e0 + (size_t)8 * DFF);
      }
    }
    float y[4];
#pragma unroll
    for (int e = 0; e < 4; ++e) {
      float cva[2];
#pragma unroll
      for (int bj = 0; bj < 2; ++bj) {
        const int jc = bj * DFF + j + e;
        cva[bj] = cb[jc] + cw[jc] * v[bj][0][e] + cw[DFF2 + jc] * v[bj][1][e] + cw[2 * DFF2 + jc] * v[bj][2][e];
      }
      y[e] = cva[0] * siluf(cva[1]);
    }
    u32x2 pk; pk[0] = pk2(y[0], y[1]); pk[1] = pk2(y[2], y[3]);
    *(u32x2*)(ACT + ((size_t)tm * 256 + (tb ? 255 : 0)) * DFF + j) = pk;
  }
}

__global__ void __launch_bounds__(NTHR) mk_fwd(Params p_unused) {
  extern __shared__ __attribute__((aligned(1024))) unsigned char shm_raw[];
  LAS unsigned char* lds = (LAS unsigned char*)shm_raw;
  cg::grid_group grid = cg::this_grid();
#ifndef REP_MASK
#define REP_MASK 0
#endif
  for (int vpc = 0; vpc < 34 * 2; ++vpc) {
    const int pc = vpc >> 1, rep = vpc & 1;
    if (rep) { if (pc < 2) { if (!((REP_MASK >> 23) & 1)) continue; } else { const int o_ = (pc - 2) % 16; const int op_ = o_ < 4 ? o_ : (o_ == 4 ? 17 : (o_ < 10 ? o_ - 1 : (o_ == 10 ? 18 : o_ - 2))); if (!((REP_MASK >> op_) & 1)) continue; } }
    PP p = (PP)__builtin_amdgcn_kernarg_segment_ptr();
    asm volatile("" : "+s"(p));
    int G = gridDim.x, c = blockIdx.x;
    asm volatile("" : "+s"(G), "+s"(c));
    const bool split = G >= 256;
    const int nglab = split ? 128 : G;
    int wG = split ? G - 128 : G;
    int wc = split ? c - 128 : c;
    unsigned char* ws = p->ws;
    bf16_t* H = (bf16_t*)(ws + WS_HY);
    float* mod = (float*)(ws + WS_MOD);
    bool sync = true;
    int gk = 0, K = 0, lda = 0, ldb = 0;
    SchedStd S; EpiBf16 E1; EpiResid E2;
    S.A = nullptr; S.B = nullptr; S.tstepA = 0; S.tstepB = 0; S.bstep_pm = 0; S.ostep_pm = 0; S.rbs = 0; S.nM = 0; S.nN = 0; S.nwg = 0; S.G = G; S.c = c; S.pm_off = 0; S.ld = 0;
    E1.O = nullptr; E1.rb_shift = 30; E1.cb_shift = 30; E1.cbs = 0; E1.rowmask = 0x7fffffff;
    E2.out = p->out; E2.cx = (float*)(ws + WS_CX); E2.gate = nullptr; E2.scale = rep ? 0.f : 1.f;
    if (pc == 0) {
      if (!(rep && ((REP_MASK >> 27) & 1))) phase_weights(p, 0, lds);
      if (!(rep && ((REP_MASK >> 28) & 1))) phase_modp(p, lds);
      if (!(rep && ((REP_MASK >> 29) & 1))) { phase_filter(p, lds); phase_fnmat(p, lds); phase_dft(p); }
    } else if (pc == 1) {
      phase_reduce(p);
    } else {
      const int layer = (pc - 2) / 16, opi = (pc - 2) % 16;
      const int op = opi < 4 ? opi : (opi == 4 ? 17 : (opi < 10 ? opi - 1 : (opi == 10 ? 18 : opi - 2)));
      const int rows_res = layer == 0 ? NTOK : NLAT;
      switch (op) {
        case 0:
          if (layer == 1) phase_weights(p, 1, lds);
          phase_norm(p, layer, 0, NTOK);
          break;
        case 1:
          S.A = (const char*)H; S.B = (const char*)(ws + WS_WTIN); S.tstepA = (size_t)256 * D * 2; S.tstepB = (size_t)256 * D * 2;
          S.nM = NTOK / 256; S.nN = NP / 256; S.ld = NP; E1.O = (bf16_t*)(ws + WS_PROJ);
          gk = 1; K = D; lda = D; ldb = D;
          break;
        case 2:
          if (c < nglab) for (int it = c; it < 128; it += nglab) gla_sweep(p, layer, it >> 3, (it >> 1) & 3, it & 1, lds, rep ? ((REP_MASK >> 24) & 7) : 0);
          sync = false;
          break;
        case 3:
          S.A = (const char*)(ws + WS_CSW) + (size_t)layer * 4 * 256 * 256 * 2; S.tstepA = (size_t)256 * 256 * 2;
          S.B = (const char*)(ws + WS_PROJ) + (size_t)C_FN * 2; S.tstepB = (size_t)256 * NP * 2; S.bstep_pm = 128 * 2;
          S.nM = 4; S.nN = NLAT / 256; S.G = wG; S.c = wc; S.ld = 4096; S.rbs = 2048; S.ostep_pm = (size_t)128 * 4096;
          E1.O = (bf16_t*)(ws + WS_UT); E1.rb_shift = 7; E1.cb_shift = 11; E1.cbs = (size_t)4 * 128 * 4096; E1.rowmask = 255;
          gk = wc >= 0 ? 1 : 0; K = 256; lda = 256; ldb = NP; sync = false;
          break;
        case 17:
          S.A = (const char*)(ws + WS_CSW) + (size_t)layer * 4 * 256 * 256 * 2; S.tstepA = (size_t)256 * 256 * 2;
          S.B = (const char*)(ws + WS_PROJ) + ((size_t)NLAT * NP + C_FN) * 2; S.tstepB = (size_t)256 * NP * 2; S.bstep_pm = 128 * 2;
          S.nM = 4; S.nN = NCTX / 256; S.G = wG; S.c = wc; S.ld = 512; S.rbs = 256; S.ostep_pm = (size_t)128 * 512;
          E1.O = (bf16_t*)(ws + WS_UTC); E1.rb_shift = 7; E1.cb_shift = 8; E1.cbs = (size_t)4 * 128 * 512; E1.rowmask = 255;
          gk = (wc >= 0 && layer == 0) ? 1 : 0; K = 256; lda = 256; ldb = NP; sync = false;
          break;
        case 4:
          if (wc >= 0) {
            for (int it = wc; it < 512 + 64; it += wG) {
              if (it < 512) item_hyprep_vt(p, layer, 0, it >> 5, it & 31, lds);
              else { const int j = it - 512; item_hyprep_vt(p, layer, 1, j >> 2, j & 3, lds); }
            }
            phase_qknorm(p, layer, wc, wG);
          }
          break;
        case 5:
          phase_gla_fin(p, layer, c, G, layer == 0 ? NTOK : NLAT);
          sync = false;
          break;
        case 6:
          wG = G; wc = c;
          S.A = (const char*)(ws + WS_DFT); S.B = (const char*)(ws + WS_UT); S.tstepA = (size_t)256 * 4096 * 2; S.tstepB = (size_t)256 * 4096 * 2;
          S.nM = 8; S.nN = 32; S.G = wG; S.c = wc; S.ld = D;
          E1.O = H + 1024; E1.cb_shift = 9; E1.cbs = (size_t)LS * D;
          gk = wc >= 0 ? 1 : 0; K = 4096; lda = 4096; ldb = 4096; sync = false;
          break;
        case 7:
          wG = G; wc = c;
          S.A = (const char*)(ws + WS_DFTC); S.B = (const char*)(ws + WS_UTC); S.tstepA = (size_t)256 * 512 * 2; S.tstepB = (size_t)256 * 512 * 2;
          S.nM = 1; S.nN = 32; S.G = wG; S.c = (wG - 1) - wc; S.ld = D;
          E1.O = H + (size_t)NLAT * D + 1024; E1.cb_shift = 9; E1.cbs = (size_t)LC * D;
          gk = (wc >= 0 && layer == 0) ? 1 : 0; K = 512; lda = 512; ldb = 512; sync = false;
          break;
        case 8:
          wG = G; wc = c;
          if (wc >= 0) {
            const int xcd = c & 7, slot = c >> 3, nslot = (G >> 3) > 0 ? (G >> 3) : 1;
            const int wid = ltid() >> 6;
            if (!(rep && ((REP_MASK >> 20) & 1))) {
              for (int cg4 = slot; cg4 < 128; cg4 += nslot) item_hyena<0>(p, layer, cg4, xcd, lds);
              if (layer == 0) for (int it = (c + G / 2) % G; it < 128; it += G) item_hyena<1>(p, layer, it, 0, lds);
            }
            if (!(rep && ((REP_MASK >> 19) & 1))) {
              LAS float* rpbl = (LAS float*)lds;
              __syncthreads();
              for (int i = ltid(); i < 15 * 31; i += NTHR) rpbl[i] = p->in[23][(size_t)(layer * 4 + (xcd & 3)) * 15 * 31 + i];
              __syncthreads();
              for (int q = slot; q < 128; q += nslot) {
                const int bh = (q >> 4) * 8 + xcd, rp = q & 15;
                item_natten(p, layer, bh >> 2, bh & 3, rp, false, lds);
              }
              if (layer == 0) for (int q = slot; q < 16; q += nslot) {
                const int bh = (q >> 1) * 8 + xcd;
                item_natten(p, layer, bh >> 2, bh & 3, q & 1, true, lds);
              }
            }
          }
          break;
        case 18:
          phase_hy_fin(p, layer, layer == 0 ? NTOK : NLAT);
          break;
        case 9:
          S.A = (const char*)H; S.B = (const char*)(ws + WS_WTOUT); S.tstepA = (size_t)256 * D * 2; S.tstepB = (size_t)256 * D * 2;
          S.nM = rows_res / 256; S.nN = D / 256; S.ld = D;
          E2.gate = mod + (size_t)layer * 17 * NMOD + 2 * D;
          gk = 2; K = D; lda = D; ldb = D;
          break;
        case 10:
          phase_norm(p, layer, 1, rows_res);
          break;
        case 11:
          S.A = (const char*)H; S.B = (const char*)(ws + WS_WTUP); S.tstepA = (size_t)256 * D * 2; S.tstepB = (size_t)256 * D * 2;
          S.nM = rows_res / 256; S.nN = DFF2 / 256; S.ld = DFF;
          gk = 3; K = D; lda = D; ldb = D;
          break;
        case 12:
          phase_ffn_edge(p, layer, rows_res / 256);
          break;
        case 13:
          S.A = (const char*)(ws + WS_ACT); S.B = (const char*)(ws + WS_WTDN); S.tstepA = (size_t)256 * DFF * 2; S.tstepB = (size_t)256 * DFF * 2;
          S.nM = rows_res / 256; S.nN = D / 256; S.ld = D;
          E2.gate = mod + (size_t)layer * 17 * NMOD + 5 * D;
          gk = 2; K = DFF; lda = DFF; ldb = DFF;
          break;
        default: break;
      }
    }
    S.nwg = S.nM * S.nN;
    if (gk == 1) gemm_phase(lds, K, lda, ldb, S, E1);
    else if (gk == 2) gemm_phase(lds, K, lda, ldb, S, E2);
    else if (gk == 3) { EpiFFN E3; E3.ACT = (bf16_t*)(ws + WS_ACT); E3.EDGE = (float*)(ws + WS_EDGE); const int layer3 = (pc - 2) / 16; E3.wcb = (const float*)(ws + WS_WCB) + (size_t)layer3 * DFF * 8; E3.halo = (LAS f32x4*)(lds + 131072); gemm_phase(lds, K, lda, ldb, S, E3); }
    if (sync || rep || ((REP_MASK >> 18) & 1)) grid.sync();
  }
}

extern "C" void kernel_launch(void* const* d_in, const int* in_sizes, int n_in, void* d_out, int out_size,
                              void* d_ws, size_t ws_size, hipStream_t stream) {
  static int grid_blocks = 0;
  if (!grid_blocks) {
    int dev = 0, cus = 0, per_cu = 0;
    (void)hipGetDevice(&dev);
    (void)hipDeviceGetAttribute(&cus, hipDeviceAttributeMultiprocessorCount, dev);
    if (hipFuncSetAttribute((const void*)mk_fwd, hipFuncAttributeMaxDynamicSharedMemorySize, LDS_BYTES) != hipSuccess)
      fprintf(stderr, "kernel_launch: hipFuncSetAttribute(%d B dynamic LDS) failed\n", LDS_BYTES);
    (void)hipOccupancyMaxActiveBlocksPerMultiprocessor(&per_cu, (const void*)mk_fwd, NTHR, LDS_BYTES);
    if (per_cu < 1) { fprintf(stderr, "kernel_launch: occupancy query returned %d\n", per_cu); per_cu = 1; }
    if (per_cu > 1) per_cu = 1;
    grid_blocks = cus * per_cu;
    if (ws_size < WS_NEED) fprintf(stderr, "kernel_launch: workspace too small: %zu < %zu\n", ws_size, (size_t)WS_NEED);
  }
  Params p{};
  for (int i = 0; i < 30; ++i) p.in[i] = (const float*)d_in[i];
  p.out = (float*)d_out; p.ws = (unsigned char*)d_ws;
  void* args[] = {&p};
  hipError_t e = hipLaunchCooperativeKernel((const void*)mk_fwd, dim3(grid_blocks), dim3(NTHR), args, LDS_BYTES, stream);
  if (e != hipSuccess) fprintf(stderr, "cooperative launch failed: %s (grid %d)\n", hipGetErrorString(e), grid_blocks);
}
```

```cpp
#include <hip/hip_runtime.h>
#include <hip/hip_cooperative_groups.h>
#include <cstdio>
namespace cg = cooperative_groups;

#define LAS __attribute__((address_space(3)))
typedef unsigned short bf16_t;
typedef short bf16x8 __attribute__((ext_vector_type(8)));
typedef float f32x4 __attribute__((ext_vector_type(4)));
typedef unsigned u32x4 __attribute__((ext_vector_type(4)));
typedef unsigned u32x2 __attribute__((ext_vector_type(2)));

constexpr int D = 2048, NB = 16, LS = 2048, LC = 256, NLAT = NB * LS, NCTX = NB * LC, NTOK = NLAT + NCTX;
constexpr int NP = 5376, DFF = 5632, DFF2 = 11264, NMOD = 12288, LALL = LS + LC;
constexpr int C_GQ = 0, C_GK = 256, C_GV = 512, C_GR = 1024, C_HY = 1536, C_FN = 3072, C_NQ = 3584, C_NK = 4096, C_NV = 4608, C_GZ = 5120;
constexpr float EPSF = 1e-6f;
constexpr int NTHR = 512;
constexpr int LDS_BYTES = 163840;

constexpr size_t al256(size_t x) { return (x + 255) & ~(size_t)255; }
constexpr size_t WS_WTIN = 0;
constexpr size_t WS_WTOUT = WS_WTIN + al256((size_t)NP * D * 2);
constexpr size_t WS_WTUP = WS_WTOUT + al256((size_t)D * D * 2);
constexpr size_t WS_WTDN = WS_WTUP + al256((size_t)DFF2 * D * 2);
constexpr size_t WS_CX = WS_WTDN + al256((size_t)D * DFF * 2);
constexpr size_t WS_HY = WS_CX + al256((size_t)NCTX * D * 4);
constexpr size_t WS_MODP = WS_HY + al256((size_t)NTOK * D * 2);
constexpr size_t WS_MOD = WS_MODP + al256((size_t)2 * 8 * 17 * NMOD * 4);
constexpr size_t WS_HFT = WS_MOD + al256((size_t)2 * 17 * NMOD * 4);
constexpr size_t WS_NORMP = WS_HFT + al256((size_t)2 * 2 * 512 * LALL * 4);
constexpr size_t WS_HNORM = WS_NORMP + al256((size_t)2 * 288 * 512 * 4);
constexpr size_t WS_CSW = WS_HNORM + al256((size_t)2 * 2 * 512 * 4);
constexpr size_t WS_DFT = WS_CSW + al256((size_t)2 * 4 * 256 * 256 * 2);
constexpr size_t WS_DFTC = WS_DFT + al256((size_t)2048 * 4096 * 2);
constexpr size_t WS_WCB = WS_DFTC + al256((size_t)256 * 512 * 2);
constexpr size_t WS_BIG = WS_WCB + al256((size_t)2 * DFF * 8 * 4);
constexpr size_t WS_PROJ = WS_BIG;
constexpr size_t WS_OGLA = WS_PROJ + al256((size_t)NTOK * NP * 2);
constexpr size_t WS_ST = WS_OGLA + al256((size_t)NTOK * 512 * 4);
constexpr size_t WS_UT = WS_ST + al256((size_t)512 * 16 * LALL * 2);
constexpr size_t WS_UTC = WS_UT + al256((size_t)8192 * 4096 * 2);
constexpr size_t WS_QN = WS_UTC + al256((size_t)8192 * 512 * 2);
constexpr size_t WS_KN = WS_QN + al256((size_t)NB * LALL * 512 * 2);
constexpr size_t WS_VT = WS_KN + al256((size_t)NB * LALL * 512 * 2);
constexpr size_t WS_END_MIX = WS_VT + al256((size_t)NB * LALL * 512 * 2);
constexpr size_t WS_ACT = WS_BIG;
constexpr size_t WS_EDGE = WS_ACT + al256((size_t)NTOK * DFF * 2);
constexpr size_t WS_END_FFN = WS_EDGE + al256((size_t)(NTOK / 256) * 4 * 2 * DFF * 4);
constexpr size_t WS_NEED = WS_END_MIX > WS_END_FFN ? WS_END_MIX : WS_END_FFN;
static_assert(WS_NEED <= (size_t)1073741824, "workspace plan exceeds 1 GiB");

struct Params {
  const float* in[30];
  float* out;
  unsigned char* ws;
};

typedef const __attribute__((address_space(4))) Params* PP;

__device__ __forceinline__ int ltid() { int t = threadIdx.x; asm volatile("" : "+v"(t)); return t; }
typedef float f32x2_t __attribute__((ext_vector_type(2)));
typedef __bf16 bf16x2_t __attribute__((ext_vector_type(2)));
__device__ __forceinline__ unsigned cvt_pk_bf16(float lo, float hi) { f32x2_t v; v[0] = lo; v[1] = hi; return __builtin_bit_cast(unsigned, __builtin_convertvector(v, bf16x2_t)); }
__device__ __forceinline__ bf16_t f2bf(float f) { return (bf16_t)(cvt_pk_bf16(f, 0.f) & 0xffffu); }
__device__ __forceinline__ float bf2f(bf16_t h) { return __uint_as_float(((unsigned)h) << 16); }
__device__ __forceinline__ unsigned pk2(float lo, float hi) { return cvt_pk_bf16(lo, hi); }
__device__ __forceinline__ float lo_bf(unsigned u) { return __uint_as_float(u << 16); }
__device__ __forceinline__ float hi_bf(unsigned u) { return __uint_as_float(u & 0xffff0000u); }
__device__ __forceinline__ float siluf(float v) { return v * __builtin_amdgcn_rcpf(1.f + __expf(-v)); }
#define LBAR() asm volatile("s_waitcnt lgkmcnt(0)\n\ts_barrier" ::: "memory")
__device__ __forceinline__ float shfl_xor_l(float v, int m) { const int l = ltid() & 63; return __builtin_bit_cast(float, __builtin_amdgcn_ds_bpermute((l ^ m) << 2, __builtin_bit_cast(int, v))); }
__device__ __forceinline__ float wave_sum(float v) {
#pragma unroll
  for (int m = 32; m >= 1; m >>= 1) v += shfl_xor_l(v, m);
  return v;
}

constexpr int BM = 256, BK = 64, HALF = 128, HTB = HALF * BK * 2, NXCD = 8, WGM = 4;
__device__ __forceinline__ int lds_byte(int r, int c) { const int st = (r >> 4) * 2 + (c >> 5), rr = r & 15, cc = c & 31, ob = rr * 64 + cc * 2; return st * 1024 + (ob ^ (((ob >> 9) & 1) << 5)); }
__device__ __forceinline__ void stage_rc(int b, int& R, int& C) { const int st = b / 1024, sb = b % 1024, swz = sb ^ (((sb >> 9) & 1) << 5); R = (st >> 1) * 16 + swz / 64; C = (st & 1) * 32 + (swz % 64) / 2; }
__device__ __forceinline__ int perm32(int rho) { const int n = rho >> 4, i = rho & 15; return 8 * (i >> 2) + 4 * n + (i & 3); }

struct Unit { const char* a; const char* b; int pm, pn; size_t o_off; int ld; size_t rbs; };

struct SchedStd {
  const char* A; const char* B; size_t tstepA, tstepB, bstep_pm, ostep_pm, rbs; int nM, nN, nwg, G, c, pm_off; int ld;
  __device__ __forceinline__ bool next(int i, Unit& u) const {
    const long L = (long)i * G + c; if (L >= nwg) return false;
    int wgid = (int)L; { const int q = nwg / NXCD, r = nwg % NXCD, xcd = wgid % NXCD, off = wgid / NXCD; wgid = (xcd < r ? xcd * (q + 1) : r * (q + 1) + (xcd - r) * q) + off; }
    const int nig = WGM * nN, gid = wgid / nig, fm = gid * WGM, gsz = (nM - fm) < WGM ? (nM - fm) : WGM;
    const int pm = fm + ((wgid % nig) % gsz), pn = (wgid % nig) / gsz;
    u.a = A + (size_t)pm * tstepA; u.b = B + (size_t)pn * tstepB + (size_t)pm * bstep_pm; u.pm = pm + pm_off; u.pn = pn; u.o_off = (size_t)pm * ostep_pm; u.ld = ld; u.rbs = rbs; return true;
  }
};


struct EpiBf16 {
  static constexpr bool PERM = true;
  bf16_t* O; int rb_shift; int cb_shift; size_t cbs; int rowmask;
  __device__ __forceinline__ void operator()(const f32x4 (&acc)[2][2][4][2], const Unit& u, int wr, int wc, int fr, int fq) const {
    const int row0 = u.pm * BM + wr * 64 + fr, col0 = u.pn * BM + wc * 32 + 8 * fq;
#pragma unroll
    for (int ai = 0; ai < 2; ++ai)
#pragma unroll
      for (int m = 0; m < 4; ++m) {
        const int row = (row0 + ai * HALF + m * 16) & rowmask;
        const size_t rbase = u.o_off + (size_t)(row & ((1 << rb_shift) - 1)) * u.ld + (size_t)(row >> rb_shift) * u.rbs;
#pragma unroll
        for (int bj = 0; bj < 2; ++bj) {
          const int col = col0 + bj * HALF;
          const size_t off = rbase + (size_t)(col & ((1 << cb_shift) - 1)) + (size_t)(col >> cb_shift) * cbs;
          const f32x4 v0 = acc[ai][bj][m][0], v1 = acc[ai][bj][m][1];
          u32x4 pk; pk[0] = cvt_pk_bf16(v0[0], v0[1]); pk[1] = cvt_pk_bf16(v0[2], v0[3]); pk[2] = cvt_pk_bf16(v1[0], v1[1]); pk[3] = cvt_pk_bf16(v1[2], v1[3]);
          *(u32x4*)(O + off) = pk;
        }
      }
  }
};

struct EpiResid {
  static constexpr bool PERM = false;
  float* out; float* cx; const float* gate; float scale;
  __device__ __forceinline__ void operator()(const f32x4 (&acc)[2][2][4][2], const Unit& u, int wr, int wc, int fr, int fq) const {
    const int row0 = u.pm * BM + wr * 64 + fr, col0 = u.pn * BM + wc * 32 + 4 * fq;
#pragma unroll
    for (int ai = 0; ai < 2; ++ai)
#pragma unroll
      for (int m = 0; m < 4; ++m) {
        const int row = row0 + ai * HALF + m * 16;
        float* rowp = (row < NLAT ? out + (size_t)row * D : cx + (size_t)(row - NLAT) * D) + col0;
        const int mb = row < NLAT ? (row >> 11) : 16;
        const float* gp = gate + (size_t)mb * NMOD + col0;
#pragma unroll
        for (int bj = 0; bj < 2; ++bj)
#pragma unroll
          for (int n = 0; n < 2; ++n) {
            const f32x4 g = *(const f32x4*)(gp + bj * HALF + n * 16);
            f32x4 x = *(f32x4*)(rowp + bj * HALF + n * 16);
            x += (g * scale) * acc[ai][bj][m][n];
            *(f32x4*)(rowp + bj * HALF + n * 16) = x;
          }
      }
  }
};

template <int CTRL> __device__ __forceinline__ float dppf(float x) { return __builtin_bit_cast(float, __builtin_amdgcn_update_dpp(0, __builtin_bit_cast(int, x), CTRL, 0xf, 0xf, true)); }

struct EpiFFN {
  static constexpr bool PERM = true;
  bf16_t* ACT; float* EDGE; const float* wcb; LAS f32x4* halo;
  __device__ __forceinline__ void operator()(const f32x4 (&acc)[2][2][4][2], const Unit& u, int wr, int wc, int fr, int fq) const {
    const int wid = wr * 4 + wc;
    LAS float* wl = (LAS float*)halo + 2048 + wid * 256;
    if (fr == 0) {
#pragma unroll
      for (int ai = 0; ai < 2; ++ai)
#pragma unroll
        for (int bj = 0; bj < 2; ++bj)
#pragma unroll
          for (int n = 0; n < 2; ++n) halo[((((wid * 2 + 0) * 2 + ai) * 2 + bj) * 4 + fq) * 2 + n] = acc[ai][bj][0][n];
    }
    if (fr == 15) {
#pragma unroll
      for (int ai = 0; ai < 2; ++ai)
#pragma unroll
        for (int bj = 0; bj < 2; ++bj)
#pragma unroll
          for (int n = 0; n < 2; ++n) halo[((((wid * 2 + 1) * 2 + ai) * 2 + bj) * 4 + fq) * 2 + n] = acc[ai][bj][3][n];
    }
    { const f32x4 wslice = *(const f32x4*)(wcb + (size_t)(u.pn * 128 + wc * 32) * 8 + (fq * 16 + fr) * 4); *(LAS f32x4*)(wl + (fq * 16 + fr) * 4) = wslice; }
    asm volatile("s_waitcnt lgkmcnt(0)" ::: "memory");
    __builtin_amdgcn_s_barrier(); __builtin_amdgcn_s_barrier();
    asm volatile("" ::: "memory");
    const int jb = u.pn * 128 + wc * 32 + 8 * fq;
    const int trow0 = wr * 64 + fr;
    const LAS float* hf = (const LAS float*)halo;
    const LAS float* wrow = wl + 8 * fq * 8;
#pragma unroll
    for (int n = 0; n < 2; ++n) {
      const int j = jb + 4 * n;
#pragma unroll
      for (int ai = 0; ai < 2; ++ai) {
        const bool hasp = (wr == 1) || (ai == 1), hasn = (wr == 0) || (ai == 0);
        const int pw = (wr == 1) ? wc : 4 + wc, pai = (wr == 1) ? ai : 0;
        const int nw = (wr == 0) ? 4 + wc : wc, nai = (wr == 0) ? ai : 1;
        unsigned actp[4][2]; float alo[4];
#pragma unroll
        for (int e = 0; e < 4; ++e) {
          const f32x4 wa = *(const LAS f32x4*)(wrow + (4 * n + e) * 8), wg = *(const LAS f32x4*)(wrow + (4 * n + e) * 8 + 4);
          const float hpa_ = hf[(((((pw * 2 + 1) * 2 + pai) * 2 + 0) * 4 + fq) * 2 + n) * 4 + e], hpg_ = hf[(((((pw * 2 + 1) * 2 + pai) * 2 + 1) * 4 + fq) * 2 + n) * 4 + e];
          const float hna_ = hf[(((((nw * 2 + 0) * 2 + nai) * 2 + 0) * 4 + fq) * 2 + n) * 4 + e], hng_ = hf[(((((nw * 2 + 0) * 2 + nai) * 2 + 1) * 4 + fq) * 2 + n) * 4 + e];
          const float hpa = hasp ? hpa_ : 0.f, hpg = hasp ? hpg_ : 0.f, hna = hasn ? hna_ : 0.f, hng = hasn ? hng_ : 0.f;
#pragma unroll
          for (int m = 0; m < 4; ++m) {
            float cva, cvg;
            {
              const float cur = acc[ai][0][m][n][e];
              const float su = dppf<0x111>(cur), sd = dppf<0x101>(cur);
              const float wu = m > 0 ? dppf<0x121>(acc[ai][0][m > 0 ? m - 1 : 0][n][e]) : hpa;
              const float wd = m < 3 ? dppf<0x12F>(acc[ai][0][m < 3 ? m + 1 : 3][n][e]) : hna;
              const float up = fr == 0 ? wu : su, dn = fr == 15 ? wd : sd;
              cva = wa[0] + wa[1] * up + wa[2] * cur + wa[3] * dn;
            }
            {
              const float cur = acc[ai][1][m][n][e];
              const float su = dppf<0x111>(cur), sd = dppf<0x101>(cur);
              const float wu = m > 0 ? dppf<0x121>(acc[ai][1][m > 0 ? m - 1 : 0][n][e]) : hpg;
              const float wd = m < 3 ? dppf<0x12F>(acc[ai][1][m < 3 ? m + 1 : 3][n][e]) : hng;
              const float up = fr == 0 ? wu : su, dn = fr == 15 ? wd : sd;
              cvg = wg[0] + wg[1] * up + wg[2] * cur + wg[3] * dn;
            }
            float av = cva * siluf(cvg);
            asm volatile("" : "+v"(av));
            if (e & 1) actp[m][e >> 1] = cvt_pk_bf16(alo[m], av); else alo[m] = av;
            if (m == 3) __builtin_amdgcn_sched_barrier(0);
          }
        }
#pragma unroll
        for (int m = 0; m < 4; ++m) {
          int trow = ai * 128 + trow0 + m * 16;
          asm volatile("" : "+v"(trow));
          const size_t row = (size_t)u.pm * BM + trow;
          if (trow != 0 && trow != 255) {
            u32x2 pk; pk[0] = actp[m][0]; pk[1] = actp[m][1];
            *(u32x2*)(ACT + row * DFF + j) = pk;
          }
          if (trow < 2 || trow >= 254) {
            const int k = trow < 2 ? trow : trow - 252;
            float* ep = EDGE + ((size_t)(u.pm * 4 + k) * 2) * DFF + j;
            *(f32x4*)ep = acc[ai][0][m][n];
            *(f32x4*)(ep + DFF) = acc[ai][1][m][n];
          }
        }
        __builtin_amdgcn_sched_barrier(0);
      }
    }
  }
};

template <class Epi, class Sched>
__device__ __forceinline__ void gemm_phase(LAS unsigned char* lds, const int K, const int lda, const int ldb, const Sched& S, const Epi& E) {
  const int tid = ltid(), wid = __builtin_amdgcn_readfirstlane(tid >> 6), lane = tid & 63, wr = wid >> 2, wc = wid & 3, fr = lane & 15, fq = lane >> 4;
  const int nt = K / BK;
  unsigned voffA[2], voffB[2];
#pragma unroll
  for (int i = 0; i < 2; ++i) { int R, C; stage_rc(tid * 16 + i * 8192, R, C); const int Rb = Epi::PERM ? ((R & ~31) + perm32(R & 31)) : R;
    voffA[i] = (unsigned)(R * lda + C) * 2u; voffB[i] = (unsigned)(Rb * ldb + C) * 2u; }
  const size_t kstep = (size_t)(BK * 2);
  const size_t hstepA = (size_t)HALF * lda * 2, hstepB = (size_t)HALF * ldb * 2;
  const unsigned ldsw = (unsigned)wid * 1024u;
  const int aoff = lds_byte(wr * 64 + fr, fq * 8), boff = lds_byte(wc * 32 + fr, fq * 8);
#define G_SA(b, h) (((b) * 2 + (h)) * HTB)
#define G_SB(b, h) ((4 + (b) * 2 + (h)) * HTB)
#define G_STAGE(bufoff, gbase, voff) do { _Pragma("unroll") for (int _i = 0; _i < 2; ++_i) \
    __builtin_amdgcn_global_load_lds((const unsigned*)((const char*)(gbase) + (voff)[_i]), (LAS unsigned*)(lds + (bufoff) + ldsw + _i * 8192), 16, 0, 0); } while (0)
#define G_LDA(dst, b, h) do { _Pragma("unroll") for (int m = 0; m < 4; ++m) _Pragma("unroll") for (int k = 0; k < 2; ++k) dst[m][k] = *(const LAS bf16x8*)(lds + G_SA(b, h) + aoff + m * 2048 + k * 1024); } while (0)
#define G_LDB(dst, b, h) do { _Pragma("unroll") for (int n = 0; n < 2; ++n) _Pragma("unroll") for (int k = 0; k < 2; ++k) dst[n][k] = *(const LAS bf16x8*)(lds + G_SB(b, h) + boff + n * 2048 + k * 1024); } while (0)
#define G_MMA(ai, bj, At, Bt) do { __builtin_amdgcn_s_setprio(1); _Pragma("unroll") for (int m = 0; m < 4; ++m) _Pragma("unroll") for (int n = 0; n < 2; ++n) _Pragma("unroll") for (int k = 0; k < 2; ++k) \
    acc[ai][bj][m][n] = __builtin_amdgcn_mfma_f32_16x16x32_bf16(Bt[n][k], At[m][k], acc[ai][bj][m][n], 0, 0, 0); __builtin_amdgcn_s_setprio(0); } while (0)
#define G_WAIT_V(n) asm volatile("s_waitcnt vmcnt(" #n ")" ::: "memory")
#define G_WAIT_L(n) asm volatile("s_waitcnt lgkmcnt(" #n ")" ::: "memory")
#define G_BAR __builtin_amdgcn_s_barrier()
#define G_SCHED __builtin_amdgcn_sched_barrier(0)
  Unit cur, nxt; int ui = 0;
  if (!S.next(0, cur)) return;
  f32x4 acc[2][2][4][2];
#pragma unroll
  for (int a = 0; a < 2; ++a)
#pragma unroll
    for (int b = 0; b < 2; ++b)
#pragma unroll
      for (int m = 0; m < 4; ++m)
#pragma unroll
        for (int n = 0; n < 2; ++n) acc[a][b][m][n] = (f32x4){0.f, 0.f, 0.f, 0.f};
  bf16x8 At[4][2], B0[2][2], B1[2][2];
  const char* cA = cur.a; const char* cB = cur.b;
  G_STAGE(G_SB(0, 0), cB, voffB); G_STAGE(G_SA(0, 0), cA, voffA); G_STAGE(G_SB(0, 1), cB + hstepB, voffB); G_STAGE(G_SA(0, 1), cA + hstepA, voffA);
  if (wr == 1) G_BAR;
  G_WAIT_V(4); G_BAR;
  G_STAGE(G_SB(1, 0), cB + kstep, voffB); G_STAGE(G_SA(1, 0), cA + kstep, voffA); G_STAGE(G_SB(1, 1), cB + hstepB + kstep, voffB);
  G_WAIT_V(6); G_BAR;
  for (;;) {
    const bool has_next = S.next(ui + 1, nxt);
    const char* nA = has_next ? nxt.a : cA; const char* nB = has_next ? nxt.b : cB;
    for (int t = 0; t < nt; t += 2) {
      const bool last = (t == nt - 2);
      const char* a1 = cA + (size_t)(t + 1) * kstep;
      const char* a2 = last ? nA : cA + (size_t)(t + 2) * kstep; const char* b2 = last ? nB : cB + (size_t)(t + 2) * kstep;
      const char* a3 = a2 + kstep; const char* b3 = b2 + kstep;
      G_LDB(B0, 0, 0); G_SCHED; G_LDA(At, 0, 0); G_STAGE(G_SA(1, 1), a1 + hstepA, voffA);
      G_WAIT_L(8); G_BAR; G_WAIT_L(0); G_MMA(0, 0, At, B0); G_BAR; G_SCHED;
      G_LDB(B1, 0, 1); G_STAGE(G_SB(0, 0), b2, voffB);
      G_BAR; G_WAIT_L(0); G_MMA(0, 1, At, B1); G_BAR;
      G_LDA(At, 0, 1); G_STAGE(G_SA(0, 0), a2, voffA);
      G_BAR; G_WAIT_L(0); G_MMA(1, 0, At, B0); G_BAR; G_SCHED;
      G_STAGE(G_SB(0, 1), b2 + hstepB, voffB);
      G_WAIT_V(6); G_BAR; G_MMA(1, 1, At, B1); G_BAR;
      G_LDB(B0, 1, 0); G_SCHED; G_LDA(At, 1, 0); G_STAGE(G_SA(0, 1), a2 + hstepA, voffA);
      G_WAIT_L(8); G_BAR; G_WAIT_L(0); G_MMA(0, 0, At, B0); G_BAR; G_SCHED;
      G_LDB(B1, 1, 1); G_STAGE(G_SB(1, 0), b3, voffB);
      G_BAR; G_WAIT_L(0); G_MMA(0, 1, At, B1); G_BAR;
      G_LDA(At, 1, 1); G_STAGE(G_SA(1, 0), a3, voffA);
      G_BAR; G_WAIT_L(0); G_MMA(1, 0, At, B0); G_BAR; G_SCHED;
      G_STAGE(G_SB(1, 1), b3 + hstepB, voffB);
      G_WAIT_V(6); G_BAR; G_MMA(1, 1, At, B1); G_BAR;
    }
    E(acc, cur, wr, wc, fr, fq);
    if (!has_next) break;
#pragma unroll
    for (int a = 0; a < 2; ++a)
#pragma unroll
      for (int b = 0; b < 2; ++b)
#pragma unroll
        for (int m = 0; m < 4; ++m)
#pragma unroll
          for (int n = 0; n < 2; ++n) acc[a][b][m][n] = (f32x4){0.f, 0.f, 0.f, 0.f};
    cur = nxt; cA = nA; cB = nB; ++ui;
  }
  G_WAIT_V(0);
  if (wr == 0) G_BAR;
  G_BAR;
#undef G_SA
#undef G_SB
#undef G_STAGE
#undef G_LDA
#undef G_LDB
#undef G_MMA
}

struct WtItem { const float* W; bf16_t* Wt; int ldw, K, k0, n0, mode; };
__device__ __forceinline__ void wt_decode(PP p, int layer, int it, WtItem& w) {
  constexpr int N_IN = 32 * 21, N_OUT = 32 * 8, N_UP = 32 * 44;
  if (it < N_IN) { w.W = p->in[7] + (size_t)layer * D * 5152; w.Wt = (bf16_t*)(p->ws + WS_WTIN); w.ldw = 5152; w.K = D; w.k0 = (it & 31) * 64; w.n0 = (it >> 5) * 256; w.mode = 1; }
  else if (it < N_IN + N_OUT) { const int j = it - N_IN; w.W = p->in[24] + (size_t)layer * D * D; w.Wt = (bf16_t*)(p->ws + WS_WTOUT); w.ldw = D; w.K = D; w.k0 = (j & 31) * 64; w.n0 = (j >> 5) * 256; w.mode = 0; }
  else if (it < N_IN + N_OUT + N_UP) { const int j = it - N_IN - N_OUT; w.W = p->in[26] + (size_t)layer * D * DFF2; w.Wt = (bf16_t*)(p->ws + WS_WTUP); w.ldw = DFF2; w.K = D; w.k0 = (j & 31) * 64; w.n0 = (j >> 5) * 256; w.mode = 2; }
  else { const int j = it - N_IN - N_OUT - N_UP; w.W = p->in[29] + (size_t)layer * DFF * D; w.Wt = (bf16_t*)(p->ws + WS_WTDN); w.ldw = D; w.K = DFF; w.k0 = (j % 88) * 64; w.n0 = (j / 88) * 256; w.mode = 0; }
}
__device__ __forceinline__ void wt_load(const WtItem& w, int tid, f32x4 (&v)[8]) {
  const int n = w.n0 + (tid & 63) * 4;
  int ns = n;
  if (w.mode == 1) ns = (n < 1536) ? n : (n < 5120 ? n + 32 : (n < 5152 ? 1536 + (n - 5120) : -1));
  if (w.mode == 2) ns = ((n >> 7) & 1) * DFF + (n >> 8) * 128 + (n & 127);
  const float* src = w.W + (size_t)(w.k0 + (tid >> 6)) * w.ldw + (ns >= 0 ? ns : 0);
#pragma unroll
  for (int i = 0; i < 8; ++i) { const f32x4 zz = {0.f, 0.f, 0.f, 0.f}; v[i] = ns >= 0 ? *(const f32x4*)(src + (size_t)(8 * i) * w.ldw) : zz; }
}
__device__ __forceinline__ void phase_weights(PP p, int layer, LAS unsigned char* lds) {
  constexpr int WS_ = 258;
  LAS bf16_t* tile = (LAS bf16_t*)lds;
  constexpr int NT = 32 * 21 + 32 * 8 + 32 * 44 + 88 * 8;
  const int tid = ltid();
  int it = blockIdx.x;
  if (it >= NT) return;
  WtItem cur; wt_decode(p, layer, it, cur);
  f32x4 v[8]; wt_load(cur, tid, v);
  for (;;) {
    const int nit = it + gridDim.x; const bool has = nit < NT;
    WtItem nxt = cur; f32x4 vn[8];
    __syncthreads();
#pragma unroll
    for (int i = 0; i < 8; ++i) {
      LAS unsigned* dst = (LAS unsigned*)(tile + ((tid >> 6) + 8 * i) * WS_ + (tid & 63) * 4);
      dst[0] = pk2(v[i][0], v[i][1]); dst[1] = pk2(v[i][2], v[i][3]);
    }
    if (has) { wt_decode(p, layer, nit, nxt); wt_load(nxt, tid, vn); }
    __syncthreads();
#pragma unroll
    for (int j = 0; j < 4; ++j) {
      const int pc_ = tid + 512 * j; const int n2 = pc_ >> 3, k8 = (pc_ & 7) * 8;
      u32x4 o;
#pragma unroll
      for (int e = 0; e < 4; ++e) o[e] = (unsigned)tile[(k8 + 2 * e) * WS_ + n2] | ((unsigned)tile[(k8 + 2 * e + 1) * WS_ + n2] << 16);
      *(u32x4*)(cur.Wt + (size_t)(cur.n0 + n2) * cur.K + cur.k0 + k8) = o;
    }
    if (!has) break;
    cur = nxt; it = nit;
#pragma unroll
    for (int i = 0; i < 8; ++i) v[i] = vn[i];
  }
  __syncthreads();
}

__device__ __forceinline__ void phase_modp(PP p, LAS unsigned char* lds) {
  LAS float* s = (LAS float*)lds;
  float* modp = (float*)(p->ws + WS_MODP);
  for (int it = blockIdx.x; it < 2 * 24 * 8; it += gridDim.x) {
    const int kc = it & 7, nc = (it >> 3) % 24, layer = it / 192;
    const int k0 = kc * 256;
    for (int idx = ltid(); idx < 17 * 256; idx += NTHR) {
      const int r = idx >> 8, k = idx & 255;
      const float v = r < 16 ? p->in[1][r * D + k0 + k] : p->in[3][k0 + k];
      s[idx] = v / (1.f + expf(-v));
    }
    __syncthreads();
    const int n = nc * 512 + ltid();
    const float* w = p->in[4] + (size_t)layer * D * NMOD + (size_t)k0 * NMOD + n;
    float acc[17];
#pragma unroll
    for (int r = 0; r < 17; ++r) acc[r] = 0.f;
    for (int k4 = 0; k4 < 64; ++k4) {
      const float w0 = w[(size_t)(4 * k4) * NMOD], w1 = w[(size_t)(4 * k4 + 1) * NMOD], w2 = w[(size_t)(4 * k4 + 2) * NMOD], w3 = w[(size_t)(4 * k4 + 3) * NMOD];
#pragma unroll
      for (int r = 0; r < 17; ++r) {
        const f32x4 sv = *(const LAS f32x4*)(s + r * 256 + 4 * k4);
        acc[r] += sv[0] * w0 + sv[1] * w1 + sv[2] * w2 + sv[3] * w3;
      }
    }
#pragma unroll
    for (int r = 0; r < 17; ++r) modp[((size_t)(layer * 8 + kc) * 17 + r) * NMOD + n] = acc[r];
    __syncthreads();
  }
}

__device__ __forceinline__ void phase_filter(PP p, LAS unsigned char* lds) {
  LAS float* z = (LAS float*)lds;
  LAS float* h1 = z + 8 * 33;
  LAS float* h2 = h1 + 8 * 64;
  float* hft = (float*)(p->ws + WS_HFT);
  float* normp = (float*)(p->ws + WS_NORMP);
  for (int it = blockIdx.x; it < 2 * 288; it += gridDim.x) {
    const int layer = it / 288, ch = it % 288;
    const int stream = ch >= 256;
    const int L = stream ? LC : LS;
    const int l0 = (stream ? ch - 256 : ch) * 8;
    const int tid = ltid();
    const float* w1 = p->in[13] + layer * 33 * 64; const float* b1 = p->in[14] + layer * 64;
    const float* w2 = p->in[15] + layer * 64 * 64; const float* b2 = p->in[16] + layer * 64;
    const float* w3 = p->in[17] + (size_t)layer * 64 * 1024; const float* fq = p->in[18] + layer * 128;
    if (tid < 8 * 33) {
      const int pp = tid / 33, j = tid % 33;
      const int l = l0 + pp;
      const float t = (float)l / (float)(L - 1);
      const float w = (6.283185307179586f / (float)L) * (float)l;
      float v;
      if (j == 0) v = t;
      else {
        const int jj = (j - 1) & 15;
        const float f = 1e-4f + (float)jj * ((15.f - 1e-4f) / 15.f);
        v = j <= 16 ? cosf(f * w) : -sinf(f * w);
      }
      z[pp * 33 + j] = v;
    }
    __syncthreads();
    {
      const int pp = tid >> 6, o = tid & 63;
      float a = b1[o];
      for (int j = 0; j < 33; ++j) a += z[pp * 33 + j] * w1[j * 64 + o];
      h1[pp * 64 + o] = sinf(fq[o] * a);
    }
    __syncthreads();
    {
      const int pp = tid >> 6, o = tid & 63;
      float a = b2[o];
      for (int j = 0; j < 64; ++j) a += h1[pp * 64 + j] * w2[j * 64 + o];
      h2[pp * 64 + o] = sinf(fq[64 + o] * a);
    }
    __syncthreads();
    {
      const int c = tid;
      float a0[8], a1[8];
#pragma unroll
      for (int q = 0; q < 8; ++q) { a0[q] = 0.f; a1[q] = 0.f; }
      for (int o = 0; o < 64; ++o) {
        const float wa = w3[o * 1024 + c], wb = w3[o * 1024 + 512 + c];
#pragma unroll
        for (int q = 0; q < 8; ++q) { const float hv = h2[q * 64 + o]; a0[q] += hv * wa; a1[q] += hv * wb; }
      }
      const float da = logf(1e-2f) / 1.5f, db = logf(1e-2f) / 0.3f;
      const float delta = fabsf(da + (float)c * ((db - da) / 511.f));
      float asum = 0.f;
      const int loff = (stream ? LS : 0) + l0;
#pragma unroll
      for (int q = 0; q < 8; ++q) {
        const float t = (float)(l0 + q) / (float)(L - 1);
        const float dec = expf(-t * delta) + 0.05f;
        const float v0 = a0[q] * dec, v1 = a1[q] * dec;
        hft[((size_t)(layer * 2 + 0) * 512 + c) * LALL + loff + q] = v0;
        hft[((size_t)(layer * 2 + 1) * 512 + c) * LALL + loff + q] = v1;
        asum += fabsf(v0) + fabsf(v1);
      }
      normp[((size_t)layer * 288 + ch) * 512 + c] = asum;
    }
    __syncthreads();
  }
}

__device__ __forceinline__ void phase_fnmat(PP p, LAS unsigned char* lds) {
  LAS float* ct = (LAS float*)lds;
  bf16_t* csw = (bf16_t*)(p->ws + WS_CSW);
  __syncthreads();
  if (ltid() < 128) ct[ltid()] = cosf((float)ltid() * (6.283185307179586f / 128.f));
  __syncthreads();
  const long nth = (long)gridDim.x * NTHR, gt = (long)blockIdx.x * NTHR + ltid();
  for (long idx = gt; idx < (long)16 * 16384; idx += nth) {
    const int e = (int)(idx & 127), d = (int)((idx >> 7) & 127), it = (int)(idx >> 14);
    const int cs = it & 1, g = (it >> 1) & 3, layer = it >> 3;
    const float* w = p->in[20] + (size_t)(layer * 4 + g) * 128 * 128 + e;
    float a = 0.f;
#pragma unroll 8
    for (int d2 = 0; d2 < 128; ++d2) {
      const int m = (d * d2) & 127;
      a += ct[cs ? ((m - 32) & 127) : m] * w[d2 * 128];
    }
    bf16_t* dst = csw + ((size_t)((layer * 4 + g) * 256 + cs * 128 + e)) * 256;
    dst[d] = f2bf(a * 0.08838834764831845f);
    dst[128 + d] = 0;
  }
  __syncthreads();
}

__device__ __forceinline__ void phase_dft(PP p) {
  {
    float* wcb = (float*)(p->ws + WS_WCB);
    const long nth0 = (long)gridDim.x * NTHR, gt0 = (long)blockIdx.x * NTHR + ltid();
    for (long idx = gt0; idx < (long)2 * DFF * 8; idx += nth0) {
      const int q = (int)(idx & 7), jc = (int)((idx >> 3) % DFF), layer = (int)(idx / (8 * DFF));
      const int col = (q >> 2) * DFF + jc;
      wcb[idx] = (q & 3) == 0 ? p->in[28][(size_t)layer * DFF2 + col] : p->in[27][((size_t)layer * 3 + ((q & 3) - 1)) * DFF2 + col];
    }
  }
  bf16_t* dft = (bf16_t*)(p->ws + WS_DFT);
  bf16_t* dftc = (bf16_t*)(p->ws + WS_DFTC);
  const long nth = (long)gridDim.x * NTHR, gt = (long)blockIdx.x * NTHR + ltid();
  for (long idx = gt; idx < (long)2048 * 4096 / 8; idx += nth) {
    const int l = (int)(idx / 512), j0 = (int)(idx % 512) * 8;
    u32x4 pk;
#pragma unroll
    for (int q = 0; q < 4; ++q) {
      float v[2];
#pragma unroll
      for (int e = 0; e < 2; ++e) {
        const int j = j0 + q * 2 + e; const int cs = j >> 11, l2 = j & 2047;
        const int m = (l * l2) & 2047;
        const float ang = (float)m * (6.283185307179586f / 2048.f);
        v[e] = (cs ? -sinf(ang) : cosf(ang)) * 0.022097086912079608f;
      }
      pk[q] = pk2(v[0], v[1]);
    }
    *(u32x4*)(dft + (size_t)l * 4096 + j0) = pk;
  }
  for (long idx = gt; idx < (long)256 * 512 / 8; idx += nth) {
    const int l = (int)(idx / 64), j0 = (int)(idx % 64) * 8;
    u32x4 pk;
#pragma unroll
    for (int q = 0; q < 4; ++q) {
      float v[2];
#pragma unroll
      for (int e = 0; e < 2; ++e) {
        const int j = j0 + q * 2 + e; const int cs = j >> 8, l2 = j & 255;
        const int m = (l * l2) & 255;
        const float ang = (float)m * (6.283185307179586f / 256.f);
        v[e] = (cs ? -sinf(ang) : cosf(ang)) * 0.0625f;
      }
      pk[q] = pk2(v[0], v[1]);
    }
    *(u32x4*)(dftc + (size_t)l * 512 + j0) = pk;
  }
}

__device__ __forceinline__ void phase_reduce(PP p) {
  const float* modp = (const float*)(p->ws + WS_MODP);
  float* mod = (float*)(p->ws + WS_MOD);
  const long nth = (long)gridDim.x * NTHR, gt = (long)blockIdx.x * NTHR + ltid();
  for (long idx = gt; idx < (long)2 * 17 * NMOD; idx += nth) {
    const int n = (int)(idx % NMOD), r = (int)((idx / NMOD) % 17), layer = (int)(idx / (17 * NMOD));
    float a = p->in[5][layer * NMOD + n];
#pragma unroll
    for (int kc = 0; kc < 8; ++kc) a += modp[((size_t)(layer * 8 + kc) * 17 + r) * NMOD + n];
    mod[idx] = a;
  }
  const float* normp = (const float*)(p->ws + WS_NORMP);
  float* hnorm = (float*)(p->ws + WS_HNORM);
  for (long idx = gt; idx < 2 * 2 * 512; idx += nth) {
    const int c = (int)(idx & 511), stream = (int)((idx >> 9) & 1), layer = (int)(idx >> 10);
    const int c0 = stream ? 256 : 0, c1 = stream ? 288 : 256;
    float a = 0.f;
    for (int ch = c0; ch < c1; ++ch) a += normp[((size_t)layer * 288 + ch) * 512 + c];
    hnorm[idx] = 1.f / (a + EPSF);
  }
}

__device__ __forceinline__ void phase_norm(PP p, int layer, int which, int nrows) {
  const int lane = ltid() & 63;
  const int gw = blockIdx.x * (NTHR / 64) + (ltid() >> 6), nw = gridDim.x * (NTHR / 64);
  const float* mod = (const float*)(p->ws + WS_MOD) + (size_t)layer * 17 * NMOD;
  const float* gain = (which ? p->in[25] : p->in[6]) + layer * D;
  bf16_t* H = (bf16_t*)(p->ws + WS_HY);
  const bool first = (layer == 0 && which == 0);
  for (int row = gw; row < nrows; row += nw) {
    const float* src = first ? (row < NLAT ? p->in[0] + (size_t)row * D : p->in[2] + (size_t)(row - NLAT) * D)
                             : (row < NLAT ? p->out + (size_t)row * D : (const float*)(p->ws + WS_CX) + (size_t)(row - NLAT) * D);
    float* dstx = row < NLAT ? p->out + (size_t)row * D : (float*)(p->ws + WS_CX) + (size_t)(row - NLAT) * D;
    f32x4 v[8];
    float ss = 0.f;
#pragma unroll
    for (int i = 0; i < 8; ++i) { v[i] = *(const f32x4*)(src + i * 256 + lane * 4); ss += v[i][0] * v[i][0] + v[i][1] * v[i][1] + v[i][2] * v[i][2] + v[i][3] * v[i][3]; }
    ss = wave_sum(ss);
    const float rinv = rsqrtf(ss * (1.f / D) + EPSF);
    const int mb = row < NLAT ? (row >> 11) : 16;
    const float* sh = mod + (size_t)mb * NMOD + (which ? 3 : 0) * D;
    const float* sc = mod + (size_t)mb * NMOD + (which ? 4 : 1) * D;
#pragma unroll
    for (int i = 0; i < 8; ++i) {
      const int c = i * 256 + lane * 4;
      const f32x4 g = *(const f32x4*)(gain + c), s1 = *(const f32x4*)(sc + c), s0 = *(const f32x4*)(sh + c);
      f32x4 h;
#pragma unroll
      for (int e = 0; e < 4; ++e) h[e] = (v[i][e] * rinv * g[e]) * (1.f + s1[e]) + s0[e];
      u32x2 pk; pk[0] = pk2(h[0], h[1]); pk[1] = pk2(h[2], h[3]);
      *(u32x2*)(H + (size_t)row * D + c) = pk;
      if (first) *(f32x4*)(dstx + c) = v[i];
    }
  }
}

__device__ __forceinline__ void item_hyprep_vt(PP p, int layer, int stream, int b, int tch, LAS unsigned char* lds) {
  LAS bf16_t* tl = (LAS bf16_t*)lds;
  const bf16_t* proj = (const bf16_t*)(p->ws + WS_PROJ);
  const int L = stream ? LC : LS;
  const int rowbase = stream ? NLAT + b * LC : b * LS;
  const int posbase = stream ? LS : 0;
  const int t0 = tch * 64, tid = ltid();
  const float* cw = p->in[11] + (size_t)layer * 3 * 1536; const float* cb = p->in[12] + layer * 1536;
  bf16_t* st = (bf16_t*)(p->ws + WS_ST);
  bf16_t* vt = (bf16_t*)(p->ws + WS_VT);
  __syncthreads();
#pragma unroll 2
  for (int i = 0; i < 8; ++i) {
    const int task = tid + 512 * i; const int tt = task >> 6, c0 = (task & 63) * 8;
    const int t = t0 + tt;
    const u32x4 zz = {0u, 0u, 0u, 0u};
    const bf16_t* rp = proj + (size_t)(rowbase + t) * NP + C_HY + 512 + c0;
    const u32x4 x1m = t > 0 ? *(const u32x4*)(rp - NP) : zz, x1c = *(const u32x4*)rp, x1p = t + 1 < L ? *(const u32x4*)(rp + NP) : zz;
    const u32x4 vm = t > 0 ? *(const u32x4*)(rp + 512 - NP) : zz, vc = *(const u32x4*)(rp + 512), vp = t + 1 < L ? *(const u32x4*)(rp + 512 + NP) : zz;
#pragma unroll
    for (int q = 0; q < 4; ++q)
#pragma unroll
      for (int e = 0; e < 2; ++e) {
        const int j1 = 512 + c0 + 2 * q + e, j2 = 1024 + c0 + 2 * q + e;
        const float u1 = cb[j1] + cw[j1] * (e ? hi_bf(x1m[q]) : lo_bf(x1m[q])) + cw[1536 + j1] * (e ? hi_bf(x1c[q]) : lo_bf(x1c[q])) + cw[3072 + j1] * (e ? hi_bf(x1p[q]) : lo_bf(x1p[q]));
        const float u2 = cb[j2] + cw[j2] * (e ? hi_bf(vm[q]) : lo_bf(vm[q])) + cw[1536 + j2] * (e ? hi_bf(vc[q]) : lo_bf(vc[q])) + cw[3072 + j2] * (e ? hi_bf(vp[q]) : lo_bf(vp[q]));
        tl[(c0 + 2 * q + e) * 72 + tt] = f2bf(u1 * u2);
      }
  }
  __syncthreads();
#pragma unroll
  for (int i = 0; i < 8; ++i) {
    const int pc_ = tid + 512 * i; const int c = pc_ >> 3, p8 = (pc_ & 7) * 8;
    *(u32x4*)(st + ((size_t)c * 16 + b) * LALL + posbase + t0 + p8) = *(const LAS u32x4*)(tl + c * 72 + p8);
  }
  __syncthreads();
#pragma unroll 4
  for (int i = 0; i < 8; ++i) {
    const int task = tid + 512 * i; const int tt = task >> 6, c0 = (task & 63) * 8;
    const u32x4 v = *(const u32x4*)(proj + (size_t)(rowbase + t0 + tt) * NP + C_NV + c0);
#pragma unroll
    for (int q = 0; q < 4; ++q) { tl[(c0 + 2 * q) * 72 + tt] = (bf16_t)(v[q] & 0xffffu); tl[(c0 + 2 * q + 1) * 72 + tt] = (bf16_t)(v[q] >> 16); }
  }
  __syncthreads();
#pragma unroll
  for (int i = 0; i < 8; ++i) {
    const int pc_ = tid + 512 * i; const int c = pc_ >> 3, p8 = (pc_ & 7) * 8;
    *(u32x4*)(vt + ((size_t)b * 512 + c) * LALL + posbase + t0 + p8) = *(const LAS u32x4*)(tl + c * 72 + p8);
  }
}

__device__ __forceinline__ void phase_qknorm(PP p, int layer, int bc, int bG) {
  const bf16_t* proj = (const bf16_t*)(p->ws + WS_PROJ);
  bf16_t* qn = (bf16_t*)(p->ws + WS_QN); bf16_t* kn = (bf16_t*)(p->ws + WS_KN);
  const int lane = ltid() & 63;
  const int gw = bc * (NTHR / 64) + (ltid() >> 6), nw = bG * (NTHR / 64);
  const float* gq = p->in[21] + layer * 128; const float* gk = p->in[22] + layer * 128;
  const int d0 = (lane & 15) * 8;
  float gqv[8], gkv[8];
#pragma unroll
  for (int e = 0; e < 8; ++e) { gqv[e] = gq[d0 + e]; gkv[e] = gk[d0 + e]; }
  for (int row = gw; row < NTOK; row += nw) {
    const int b = row < NLAT ? (row >> 11) : ((row - NLAT) >> 8);
    const int pos = row < NLAT ? (row & 2047) : LS + ((row - NLAT) & 255);
    const u32x4 qv = *(const u32x4*)(proj + (size_t)row * NP + C_NQ + lane * 8);
    const u32x4 kv = *(const u32x4*)(proj + (size_t)row * NP + C_NK + lane * 8);
    float qf[8], kf[8]; float sq = 0.f, sk = 0.f;
#pragma unroll
    for (int e = 0; e < 4; ++e) { qf[2 * e] = lo_bf(qv[e]); qf[2 * e + 1] = hi_bf(qv[e]); kf[2 * e] = lo_bf(kv[e]); kf[2 * e + 1] = hi_bf(kv[e]); }
#pragma unroll
    for (int e = 0; e < 8; ++e) { sq += qf[e] * qf[e]; sk += kf[e] * kf[e]; }
#pragma unroll
    for (int m = 8; m >= 1; m >>= 1) { sq += shfl_xor_l(sq, m); sk += shfl_xor_l(sk, m); }
    const float rq = rsqrtf(sq * (1.f / 128.f) + EPSF) * 0.08838834764831845f, rk = rsqrtf(sk * (1.f / 128.f) + EPSF);
    u32x4 oq, ok;
#pragma unroll
    for (int e = 0; e < 4; ++e) {
      oq[e] = pk2(qf[2 * e] * rq * gqv[2 * e], qf[2 * e + 1] * rq * gqv[2 * e + 1]);
      ok[e] = pk2(kf[2 * e] * rk * gkv[2 * e], kf[2 * e + 1] * rk * gkv[2 * e + 1]);
    }
    const size_t o = ((size_t)b * LALL + pos) * 512 + lane * 8;
    *(u32x4*)(qn + o) = oq; *(u32x4*)(kn + o) = ok;
  }
}

template <int STREAM>
__device__ __forceinline__ void item_hyena(PP p, int layer, int cg4, int tr, LAS unsigned char* lds) {
  constexpr int L = STREAM ? LC : LS;
  constexpr int TL = STREAM ? 520 : 2312;
  constexpr int NK = STREAM ? 1 : 8;
  constexpr int SBS = 2056;
  constexpr int posbase = STREAM ? LS : 0;
  const int T0 = tr * 256;
  const int base = L - 256 - T0;
  LAS bf16_t* tab = (LAS bf16_t*)lds;
  LAS bf16_t* sB = (LAS bf16_t*)(lds + 36992);
  LAS bf16_t* outs = (LAS bf16_t*)(lds + 102784);
  LAS float* gl = (LAS float*)(lds + 135552);
  LAS int* outi = (LAS int*)(lds + 144800);
  const float* hft = (const float*)(p->ws + WS_HFT);
  const float* hnorm = (const float*)(p->ws + WS_HNORM);
  const bf16_t* st = (const bf16_t*)(p->ws + WS_ST);
  const float* hbias_ = p->in[19] + layer * 512;
  const int tid = ltid(), wid = tid >> 6, lane = tid & 63, fr = lane & 15, fq = lane >> 4;
  constexpr int ngl = STREAM ? 1 : 5, nb = STREAM ? 1 : 8;
  constexpr int cshift = STREAM ? 5 : 8;
  float glr[ngl]; u32x4 br[nb];
#define HY_LOAD(ch_) do { const int c_ = cg4 * 4 + (ch_); const float inv_ = hnorm[(layer * 2 + STREAM) * 512 + c_]; \
    const float* hf0_ = hft + ((size_t)(layer * 2 + 0) * 512 + c_) * LALL + posbase; const float* hf1_ = hft + ((size_t)(layer * 2 + 1) * 512 + c_) * LALL + posbase; \
    _Pragma("unroll") for (int i = 0; i < ngl; ++i) { const int j = tid + 512 * i; float v = 0.f; \
      if (j < 255 + L) { const int dd = L - 1 - (base + j); v = dd > 0 ? hf0_[dd] * inv_ : (dd < 0 ? hf1_[-dd] * inv_ : (hf0_[0] + hf1_[0]) * inv_ + hbias_[c_]); } glr[i] = v; } \
    _Pragma("unroll") for (int i = 0; i < nb; ++i) { const int idx = tid + 512 * i; const int b_ = idx >> cshift, c8_ = idx & ((1 << cshift) - 1); \
      br[i] = *(const u32x4*)(st + ((size_t)c_ * 16 + b_) * LALL + posbase + c8_ * 8); } } while (0)
  HY_LOAD(0);
#pragma unroll
  for (int i = 0; i < 8; ++i) outi[tid + 512 * i] = 0;
  for (int ch = 0; ch < 4; ++ch) {
    LBAR();
#pragma unroll
    for (int i = 0; i < ngl; ++i) {
      const int j = tid + 512 * i;
      if (j < 255 + L) {
        const bf16_t v = f2bf(glr[i]);
#pragma unroll
        for (int r = 0; r < 8; ++r) if (j - r >= 0) tab[r * TL + j - r] = v;
      }
    }
#pragma unroll
    for (int i = 0; i < nb; ++i) { const int idx = tid + 512 * i; const int b_ = idx >> cshift, c8_ = idx & ((1 << cshift) - 1); *(LAS u32x4*)(sB + b_ * SBS + c8_ * 8) = br[i]; }
    if (ch + 1 < 4) HY_LOAD(ch + 1);
    LBAR();
    {
      const int r = 7 - (fr & 7);
      const int Sw = 32 * NK * wid;
      const LAS bf16_t* tb = tab + r * TL + (255 - fr - r) + 8 * fq + Sw;
      bf16x8 Bf[NK];
#pragma unroll
      for (int k = 0; k < NK; ++k) Bf[k] = *(const LAS bf16x8*)(sB + fr * SBS + 8 * fq + Sw + 32 * k);
      f32x4 acc[16];
#pragma unroll
      for (int mt = 0; mt < 16; ++mt) acc[mt] = (f32x4){0.f, 0.f, 0.f, 0.f};
#pragma unroll
      for (int q = -15; q <= 2 * (NK - 1); ++q) {
        const bf16x8 af = *(const LAS bf16x8*)(tb + 16 * q);
#pragma unroll
        for (int k = 0; k < NK; ++k) {
          const int mt = 2 * k - q;
          if (mt >= 0 && mt < 16) acc[mt] = __builtin_amdgcn_mfma_f32_16x16x32_bf16(af, Bf[k], acc[mt], 0, 0, 0);
        }
      }
#pragma unroll
      for (int mt = 0; mt < 16; ++mt)
#pragma unroll
        for (int j = 0; j < 4; ++j) __hip_atomic_fetch_add(outi + (16 * mt + 4 * fq + j) * 16 + fr, __float2int_rn(acc[mt][j] * 1048576.f), __ATOMIC_RELAXED, __HIP_MEMORY_SCOPE_WORKGROUP);
    }
    LBAR();
#pragma unroll
    for (int i = 0; i < 8; ++i) { const int idx = tid + 512 * i; outs[idx * 4 + ch] = f2bf((float)outi[idx] * (1.f / 1048576.f)); outi[idx] = 0; }
  }
#undef HY_LOAD
  LBAR();
  bf16_t* proj = (bf16_t*)(p->ws + WS_PROJ);
  const int c0 = cg4 * 4;
#pragma unroll
  for (int i = 0; i < 8; ++i) {
    const int pi = tid + 512 * i;
    const int tl = pi >> 4, b = pi & 15;
    const int row = (STREAM ? NLAT + b * LC : b * LS) + T0 + tl;
    *(u32x2*)(proj + (size_t)row * NP + C_HY + 512 + c0) = *(const LAS u32x2*)(outs + (size_t)pi * 4);
  }
  LBAR();
}

__device__ __forceinline__ void phase_hy_fin(PP p, int layer, int nrows) {
  const bf16_t* proj = (const bf16_t*)(p->ws + WS_PROJ);
  bf16_t* Y = (bf16_t*)(p->ws + WS_HY);
  const float* cw = p->in[11] + (size_t)layer * 3 * 1536; const float* cb = p->in[12] + layer * 1536;
  const long nth = (long)gridDim.x * NTHR, gt = (long)blockIdx.x * NTHR + ltid();
  for (long idx = gt; idx < (long)nrows * 64; idx += nth) {
    const int c0 = (int)(idx & 63) * 8; const int row = (int)(idx >> 6);
    const int L = row < NLAT ? LS : LC;
    const int t = row < NLAT ? (row & 2047) : ((row - NLAT) & 255);
    const u32x4 zz = {0u, 0u, 0u, 0u};
    const bf16_t* rp = proj + (size_t)row * NP + C_HY + c0;
    const u32x4 xm = t > 0 ? *(const u32x4*)(rp - NP) : zz, x0 = *(const u32x4*)rp, xp = t + 1 < L ? *(const u32x4*)(rp + NP) : zz;
    const u32x4 cv = *(const u32x4*)(rp + 512);
    u32x4 pk;
#pragma unroll
    for (int q = 0; q < 4; ++q) {
      float y[2];
#pragma unroll
      for (int e = 0; e < 2; ++e) {
        const int c = c0 + q * 2 + e;
        const float u0 = cb[c] + cw[c] * (e ? hi_bf(xm[q]) : lo_bf(xm[q])) + cw[1536 + c] * (e ? hi_bf(x0[q]) : lo_bf(x0[q])) + cw[3072 + c] * (e ? hi_bf(xp[q]) : lo_bf(xp[q]));
        y[e] = (e ? hi_bf(cv[q]) : lo_bf(cv[q])) * u0;
      }
      pk[q] = pk2(y[0], y[1]);
    }
    *(u32x4*)(Y + (size_t)row * D + 512 + c0) = pk;
  }
}

constexpr int NA_KS = 136, NA_VS = 72;
__device__ __forceinline__ void na_pair(const LAS bf16_t* kb, const LAS bf16_t* vb, const bf16x8 (&qf)[4], f32x4 (&o)[8], float& lsum,
                                        bool local, int kcb, int krow, int r, int qc, int col0, int fq, const LAS float* rpb) {
  f32x4 s0 = {0.f, 0.f, 0.f, 0.f}, s1 = {0.f, 0.f, 0.f, 0.f};
#pragma unroll
  for (int ks = 0; ks < 4; ++ks) {
    const bf16x8 k0 = *(const LAS bf16x8*)(kb + 32 * ks), k1 = *(const LAS bf16x8*)(kb + 16 * NA_KS + 32 * ks);
    s0 = __builtin_amdgcn_mfma_f32_16x16x32_bf16(k0, qf[ks], s0, 0, 0, 0);
    s1 = __builtin_amdgcn_mfma_f32_16x16x32_bf16(k1, qf[ks], s1, 0, 0, 0);
  }
  float pv[8];
#pragma unroll
  for (int j = 0; j < 8; ++j) {
    const float sv = j < 4 ? s0[j] : s1[j - 4];
    float pe;
    if (local) {
      const int kc = kcb + (j < 4 ? 0 : 16) + 4 * fq + (j & 3);
      const bool inw = (kc >= col0) && (kc < col0 + 16);
      const int dr = krow - r + 7;
      const int dc = min(max(kc - qc + 15, 0), 30);
      pe = inw ? __expf(sv + rpb[dr * 31 + dc]) : 0.f;
    } else pe = __expf(sv);
    pv[j] = pe; lsum += pe;
  }
  bf16x8 pf;
  {
    u32x4 t; t[0] = pk2(pv[0], pv[1]); t[1] = pk2(pv[2], pv[3]); t[2] = pk2(pv[4], pv[5]); t[3] = pk2(pv[6], pv[7]);
    pf = __builtin_bit_cast(bf16x8, t);
  }
#pragma unroll
  for (int dt = 0; dt < 8; ++dt) {
    const u32x2 va = *(const LAS u32x2*)(vb + 16 * dt * NA_VS), vbb = *(const LAS u32x2*)(vb + 16 * dt * NA_VS + 16);
    u32x4 t; t[0] = va[0]; t[1] = va[1]; t[2] = vbb[0]; t[3] = vbb[1];
    o[dt] = __builtin_amdgcn_mfma_f32_16x16x32_bf16(__builtin_bit_cast(bf16x8, t), pf, o[dt], 0, 0, 0);
  }
}

__device__ __forceinline__ void item_natten(PP p, int layer, int b, int h, int rp, bool isctx, LAS unsigned char* lds) {
  const LAS float* rpb = (const LAS float*)lds;
  LAS bf16_t* Kt = (LAS bf16_t*)(lds + 2048);
  LAS bf16_t* Vtt = Kt + 3 * 64 * NA_KS;
  const bf16_t* qn = (const bf16_t*)(p->ws + WS_QN) + (size_t)b * LALL * 512 + h * 128;
  const bf16_t* kn = (const bf16_t*)(p->ws + WS_KN) + (size_t)b * LALL * 512 + h * 128;
  const bf16_t* vt = (const bf16_t*)(p->ws + WS_VT) + ((size_t)b * 512 + h * 128) * LALL;
  const int tid = ltid(), wid = tid >> 6, lane = tid & 63, fr = lane & 15, fq = lane >> 4;
  const int r = isctx ? 0 : 2 * rp + (wid >> 2);
  const int qt = isctx ? rp * 8 + wid : (wid & 3);
  const int qpos = isctx ? LS + 16 * qt + fr : r * 64 + 16 * qt + fr;
  bf16x8 qf[4];
#pragma unroll
  for (int ks = 0; ks < 4; ++ks) qf[ks] = *(const bf16x8*)(qn + (size_t)qpos * 512 + 32 * ks + 8 * fq);
  f32x4 o[8];
#pragma unroll
  for (int dt = 0; dt < 8; ++dt) o[dt] = (f32x4){0.f, 0.f, 0.f, 0.f};
  float lsum = 0.f;
  const int qc = 16 * qt + fr;
  const int col0 = min(max(qc - 8, 0), 48);
  const int kr0 = min(max(r - 4, 0), 24);
  const int kr_lo = min(max(2 * rp - 4, 0), 24), kr_hi = min(max(2 * rp - 3, 0), 24) + 7;
  const int nloc = isctx ? 0 : (kr_hi - kr_lo + 1);
  const int nstage = nloc + 4;
  const int lkey = tid >> 4, lkp = tid & 15, ldd = tid >> 2, lvp = tid & 3;
#define NA_P0(j_) ((j_) < nloc ? (kr_lo + (j_)) * 64 : LS + 64 * ((j_) - nloc))
#define NA_LOAD(S_, P0_) do { S_##k0 = *(const u32x4*)(kn + (size_t)((P0_) + lkey) * 512 + lkp * 8); S_##k1 = *(const u32x4*)(kn + (size_t)((P0_) + 32 + lkey) * 512 + lkp * 8); \
    S_##v0 = *(const u32x4*)(vt + (size_t)ldd * LALL + (P0_) + lvp * 8); S_##v1 = *(const u32x4*)(vt + (size_t)ldd * LALL + (P0_) + 32 + lvp * 8); } while (0)
#define NA_STORE(S_, buf_) do { LAS bf16_t* kd_ = Kt + (buf_) * 64 * NA_KS; LAS bf16_t* vd_ = Vtt + (buf_) * 128 * NA_VS; \
    *(LAS u32x4*)(kd_ + lkey * NA_KS + lkp * 8) = S_##k0; *(LAS u32x4*)(kd_ + (32 + lkey) * NA_KS + lkp * 8) = S_##k1; \
    *(LAS u32x4*)(vd_ + ldd * NA_VS + lvp * 8) = S_##v0; *(LAS u32x4*)(vd_ + ldd * NA_VS + 32 + lvp * 8) = S_##v1; } while (0)
  u32x4 Ak0, Ak1, Av0, Av1, Bk0, Bk1, Bv0, Bv1;
  { const int P0 = NA_P0(0); NA_LOAD(A, P0); }
  LBAR();
  NA_STORE(A, 0);
  if (nstage > 1) { const int P1 = NA_P0(1); NA_LOAD(B, P1); }
  LBAR();
#define NA_BODY(it_, X_, Y_) do { const int it = (it_); \
    const int P0 = NA_P0(it); const bool local = it < nloc; const int bufc = it % 3; \
    if (it + 2 < nstage) { const int P2 = NA_P0(it + 2); NA_LOAD(X_, P2); } \
    const int krow = P0 >> 6; \
    const bool rowrel = !local || (krow >= kr0 && krow < kr0 + 8); \
    _Pragma("unroll") for (int pr = 0; pr < 2; ++pr) { \
      const int kcb = 32 * pr; \
      const bool rel = rowrel && !(local && ((qt == 0 && pr == 1) || (qt == 3 && pr == 0))); \
      if (rel) na_pair(Kt + bufc * 64 * NA_KS + (kcb + fr) * NA_KS + 8 * fq, Vtt + bufc * 128 * NA_VS + fr * NA_VS + kcb + 4 * fq, qf, o, lsum, local, kcb, krow, r, qc, col0, fq, rpb); \
    } \
    if (it + 1 < nstage) NA_STORE(Y_, (it + 1) % 3); \
    LBAR(); } while (0)
  for (int it2 = 0; it2 < nstage; it2 += 2) {
    NA_BODY(it2, A, B);
    if (it2 + 1 < nstage) NA_BODY(it2 + 1, B, A);
  }
#undef NA_BODY
#undef NA_P0
#undef NA_LOAD
#undef NA_STORE
  lsum += shfl_xor_l(lsum, 16); lsum += shfl_xor_l(lsum, 32);
  const float il = 1.f / lsum;
  bf16_t* Y = (bf16_t*)(p->ws + WS_HY);
  const int row = isctx ? NLAT + b * LC + 16 * qt + fr : b * LS + r * 64 + 16 * qt + fr;
#pragma unroll
  for (int dt = 0; dt < 8; ++dt) {
    u32x2 pk; pk[0] = pk2(o[dt][0] * il, o[dt][1] * il); pk[1] = pk2(o[dt][2] * il, o[dt][3] * il);
    *(u32x2*)(Y + (size_t)row * D + 1536 + h * 128 + 16 * dt + 4 * fq) = pk;
  }
}

constexpr int GS = 72;
constexpr int QS = 68;
constexpr int OS = 136;
#define GLA_BAR() asm volatile("s_waitcnt lgkmcnt(0)\n\ts_barrier" ::: "memory")
__device__ __forceinline__ void gla_sweep(PP p, int layer, int b, int h, int dir, LAS unsigned char* lds, int variant = 0) {
  LAS bf16_t* Qd = (LAS bf16_t*)lds;
  LAS bf16_t* Ki = Qd + 64 * GS;
  LAS bf16_t* KeT = Ki + 64 * GS;
  LAS bf16_t* Pm = KeT + 64 * GS;
  LAS bf16_t* Vt = Pm + 64 * GS;
  LAS bf16_t* St = Vt + 128 * GS;
  LAS float* segs = (LAS float*)(St + 128 * GS);
  LAS float* decay = segs + 512;
  LAS float* zf = decay + 64;
  LAS float* Qraw = zf + 1024;
  LAS float* Kraw = Qraw + 64 * QS;
  LAS float* crow = Kraw + 64 * QS;
  LAS float* srow = crow + 512;
  LAS bf16_t* Ot = (LAS bf16_t*)(srow + 512);
  const bf16_t* proj = (const bf16_t*)(p->ws + WS_PROJ);
  bf16_t* obuf = (bf16_t*)(p->ws + (variant ? WS_UT : WS_OGLA)) + (size_t)dir * NTOK * 512;
  const int tid = ltid(), wid = tid >> 6, lane = tid & 63, fr = lane & 15, fq = lane >> 4;
  const int dk = tid & 63, seg = tid >> 6;
  const int lpos = tid >> 3, lg = tid & 7;
  float wg[16];
  {
    const float* gw = p->in[8] + (size_t)((layer * 2 + dir) * 16) * 256 + h * 64 + dk;
#pragma unroll
    for (int r = 0; r < 16; ++r) wg[r] = gw[r * 256];
  }
  const float bg = p->in[9][(layer * 2 + dir) * 256 + h * 64 + dk];
  const float inv = powf(10000.f, -(float)(dk & 15) / 16.f);
  const int which = dk >> 5; const bool first = (dk & 31) < 16; const int partner = dk ^ 16;
  float cs8[8], sn8[8];
#pragma unroll
  for (int i = 0; i < 8; ++i) sincosf((float)(8 * seg + i) * inv, &sn8[i], &cs8[i]);
  f32x4 S[4];
#pragma unroll
  for (int i = 0; i < 4; ++i) S[i] = (f32x4){0.f, 0.f, 0.f, 0.f};
  GLA_BAR();
  { const int rr = tid >> 4, ff = tid & 15; float sn_, cs_; sincosf((float)rr * powf(10000.f, -(float)ff / 16.f), &sn_, &cs_); crow[tid] = cs_; srow[tid] = sn_; }
#pragma unroll
  for (int dkt = 0; dkt < 4; ++dkt) { u32x2 zz = {0u, 0u}; *(LAS u32x2*)(St + (16 * wid + fr) * GS + 16 * dkt + 4 * fq) = zz; }
  u32x4 rq, rk, rv0, rv1, rz;
#define GLA_ROW0(step_) (((step_) < 4) ? NLAT + b * LC + 64 * (dir == 0 ? (step_) : 3 - (step_)) : b * LS + 64 * (dir == 0 ? (step_) - 4 : 35 - (step_)))
#define GLA_LOAD(step_) do { const int r0_ = GLA_ROW0(step_); const bf16_t* rp_ = proj + (size_t)(r0_ + lpos) * NP; \
    rq = *(const u32x4*)(rp_ + C_GQ + h * 64 + lg * 8); rk = *(const u32x4*)(rp_ + C_GK + h * 64 + lg * 8); \
    { const bf16_t* vp_ = proj + (size_t)(r0_ + lane) * NP + C_GV + h * 128 + 16 * wid; rv0 = *(const u32x4*)vp_; rv1 = *(const u32x4*)(vp_ + 8); } \
    if (tid < 128) rz = *(const u32x4*)(proj + (size_t)(r0_ + (tid >> 1)) * NP + C_GZ + dir * 16 + (tid & 1) * 8); } while (0)
  GLA_LOAD(0);
  bool prev_o = false; int prev_row0 = 0;
  for (int step = 0; step < 36; ++step) {
    const bool isctx = step < 4;
    const int cidx = dir == 0 ? (isctx ? step : step - 4) : (isctx ? 3 - step : 35 - step);
    const int row0 = GLA_ROW0(step);
    const bool need_o = !(isctx && layer == 1);
    GLA_BAR();
    {
      f32x4 a, c2;
      a[0] = lo_bf(rq[0]); a[1] = hi_bf(rq[0]); a[2] = lo_bf(rq[1]); a[3] = hi_bf(rq[1]); c2[0] = lo_bf(rq[2]); c2[1] = hi_bf(rq[2]); c2[2] = lo_bf(rq[3]); c2[3] = hi_bf(rq[3]);
      *(LAS f32x4*)(Qraw + lpos * QS + lg * 8) = a; *(LAS f32x4*)(Qraw + lpos * QS + lg * 8 + 4) = c2;
      a[0] = lo_bf(rk[0]); a[1] = hi_bf(rk[0]); a[2] = lo_bf(rk[1]); a[3] = hi_bf(rk[1]); c2[0] = lo_bf(rk[2]); c2[1] = hi_bf(rk[2]); c2[2] = lo_bf(rk[3]); c2[3] = hi_bf(rk[3]);
      *(LAS f32x4*)(Kraw + lpos * QS + lg * 8) = a; *(LAS f32x4*)(Kraw + lpos * QS + lg * 8 + 4) = c2;
#pragma unroll
      for (int e = 0; e < 4; ++e) {
        Vt[(16 * wid + 2 * e) * GS + lane] = (bf16_t)(rv0[e] & 0xffffu); Vt[(16 * wid + 2 * e + 1) * GS + lane] = (bf16_t)(rv0[e] >> 16);
        Vt[(16 * wid + 8 + 2 * e) * GS + lane] = (bf16_t)(rv1[e] & 0xffffu); Vt[(16 * wid + 8 + 2 * e + 1) * GS + lane] = (bf16_t)(rv1[e] >> 16);
      }
      if (tid < 128) {
        a[0] = lo_bf(rz[0]); a[1] = hi_bf(rz[0]); a[2] = lo_bf(rz[1]); a[3] = hi_bf(rz[1]); c2[0] = lo_bf(rz[2]); c2[1] = hi_bf(rz[2]); c2[2] = lo_bf(rz[3]); c2[3] = hi_bf(rz[3]);
        *(LAS f32x4*)(zf + (tid >> 1) * 16 + (tid & 1) * 8) = a; *(LAS f32x4*)(zf + (tid >> 1) * 16 + (tid & 1) * 8 + 4) = c2;
      }
    }
    if (step > 0 && prev_o) {
#pragma unroll
      for (int i2 = 0; i2 < 2; ++i2) { const int pc_ = tid + 512 * i2; const int pr_ = pc_ >> 4, pp_ = pc_ & 15;
        *(u32x4*)(obuf + (size_t)(prev_row0 + pr_) * 512 + h * 128 + pp_ * 8) = *(const LAS u32x4*)(Ot + pr_ * OS + pp_ * 8); }
    }
    if (step + 1 < 36 && !(variant & 4)) GLA_LOAD(step + 1);
    GLA_BAR();
    prev_o = need_o && !(variant & 4); prev_row0 = row0;
    float cum[8]; float segtot = 0.f;
    if (variant & 2) { for (int i = 0; i < 8; ++i) cum[i] = -0.01f; } else
#pragma unroll
    for (int i = 0; i < 8; ++i) {
      const int pos = 8 * seg + i;
      float x = bg;
#pragma unroll
      for (int r = 0; r < 16; ++r) x += zf[pos * 16 + r] * wg[r];
      const float ls = fminf(x, 0.f) - __logf(1.f + __expf(-fabsf(x)));
      cum[i] = ls * (1.f / 16.f);
      segtot += cum[i];
    }
    if (dir == 0) {
#pragma unroll
      for (int i = 1; i < 8; ++i) cum[i] += cum[i - 1];
    } else {
#pragma unroll
      for (int i = 6; i >= 0; --i) cum[i] += cum[i + 1];
    }
    segs[seg * 64 + dk] = segtot;
    GLA_BAR();
    float offs = 0.f, total = 0.f;
#pragma unroll
    for (int s = 0; s < 8; ++s) { const float v = segs[s * 64 + dk]; total += v; if (dir == 0 ? (s < seg) : (s > seg)) offs += v; }
    if (seg == 0) decay[dk] = __expf(total);
    const float csr = crow[(isctx ? 0 : cidx) * 16 + (dk & 15)], snr = srow[(isctx ? 0 : cidx) * 16 + (dk & 15)];
    unsigned kev[4] = {0u, 0u, 0u, 0u};
    if (!(variant & 2))
#pragma unroll
    for (int i = 0; i < 8; ++i) {
      const int pos = 8 * seg + i;
      float q = Qraw[pos * QS + dk], k = Kraw[pos * QS + dk];
      if (!isctx) {
        const float qp = Qraw[pos * QS + partner], kp = Kraw[pos * QS + partner];
        const float cs = which ? cs8[i] : csr, sn = which ? sn8[i] : snr;
        q = first ? q * cs - qp * sn : qp * sn + q * cs;
        k = first ? k * cs - kp * sn : kp * sn + k * cs;
      }
      q *= 0.125f;
      const float c = cum[i] + offs;
      Qd[pos * GS + dk] = f2bf(q * __expf(c));
      Ki[pos * GS + dk] = f2bf(k * __expf(-c));
      { const unsigned kb_ = f2bf(k * __expf(total - c)); if (i & 1) kev[i >> 1] |= kb_ << 16; else kev[i >> 1] = kb_; }
    }
    { u32x4 kv4; kv4[0] = kev[0]; kv4[1] = kev[1]; kv4[2] = kev[2]; kv4[3] = kev[3]; *(LAS u32x4*)(KeT + dk * GS + 8 * seg) = kv4; }
    GLA_BAR();
    if (need_o && !(variant & 1)) {
      const int it = wid >> 1;
#pragma unroll
      for (int jj = 0; jj < 2; ++jj) {
        const int jt = (wid & 1) * 2 + jj;
        f32x4 acc = {0.f, 0.f, 0.f, 0.f};
#pragma unroll
        for (int ks = 0; ks < 2; ++ks) {
          const bf16x8 a = *(const LAS bf16x8*)(Qd + (16 * it + fr) * GS + 32 * ks + 8 * fq);
          const bf16x8 bb = *(const LAS bf16x8*)(Ki + (16 * jt + fr) * GS + 32 * ks + 8 * fq);
          acc = __builtin_amdgcn_mfma_f32_16x16x32_bf16(a, bb, acc, 0, 0, 0);
        }
#pragma unroll
        for (int j = 0; j < 4; ++j) {
          const int i = 16 * it + 4 * fq + j, jc = 16 * jt + fr;
          const bool keep = dir == 0 ? (jc <= i) : (jc >= i);
          Pm[i * GS + jc] = f2bf(keep ? acc[j] : 0.f);
        }
      }
    }
    GLA_BAR();
    if (need_o && !(variant & 1)) {
#pragma unroll
      for (int it2 = 0; it2 < 4; ++it2) {
        f32x4 acc = {0.f, 0.f, 0.f, 0.f};
#pragma unroll
        for (int ks = 0; ks < 2; ++ks) {
          const bf16x8 a = *(const LAS bf16x8*)(Pm + (16 * it2 + fr) * GS + 32 * ks + 8 * fq);
          const bf16x8 bb = *(const LAS bf16x8*)(Vt + (16 * wid + fr) * GS + 32 * ks + 8 * fq);
          acc = __builtin_amdgcn_mfma_f32_16x16x32_bf16(a, bb, acc, 0, 0, 0);
          const bf16x8 a2 = *(const LAS bf16x8*)(Qd + (16 * it2 + fr) * GS + 32 * ks + 8 * fq);
          const bf16x8 b2 = *(const LAS bf16x8*)(St + (16 * wid + fr) * GS + 32 * ks + 8 * fq);
          acc = __builtin_amdgcn_mfma_f32_16x16x32_bf16(a2, b2, acc, 0, 0, 0);
        }
#pragma unroll
        for (int j = 0; j < 4; ++j) Ot[(16 * it2 + 4 * fq + j) * OS + 16 * wid + fr] = f2bf(acc[j]);
      }
    }
    if (!(variant & 1))
#pragma unroll
    for (int dkt = 0; dkt < 4; ++dkt) {
      f32x4 s = S[dkt];
#pragma unroll
      for (int j = 0; j < 4; ++j) s[j] *= decay[16 * dkt + 4 * fq + j];
#pragma unroll
      for (int ks = 0; ks < 2; ++ks) {
        const bf16x8 a = *(const LAS bf16x8*)(KeT + (16 * dkt + fr) * GS + 32 * ks + 8 * fq);
        const bf16x8 bb = *(const LAS bf16x8*)(Vt + (16 * wid + fr) * GS + 32 * ks + 8 * fq);
        s = __builtin_amdgcn_mfma_f32_16x16x32_bf16(a, bb, s, 0, 0, 0);
      }
      S[dkt] = s;
      u32x2 pk; pk[0] = pk2(s[0], s[1]); pk[1] = pk2(s[2], s[3]);
      *(LAS u32x2*)(St + (16 * wid + fr) * GS + 16 * dkt + 4 * fq) = pk;
    }
  }
#undef GLA_LOAD
#undef GLA_ROW0
  GLA_BAR();
  if (prev_o) {
#pragma unroll
    for (int i2 = 0; i2 < 2; ++i2) { const int pc_ = tid + 512 * i2; const int pr_ = pc_ >> 4, pp_ = pc_ & 15;
      *(u32x4*)(obuf + (size_t)(prev_row0 + pr_) * 512 + h * 128 + pp_ * 8) = *(const LAS u32x4*)(Ot + pr_ * OS + pp_ * 8); }
  }
  GLA_BAR();
}

__device__ __forceinline__ void phase_gla_fin(PP p, int layer, int bc, int bG, int nrows) {
  const bf16_t* proj = (const bf16_t*)(p->ws + WS_PROJ);
  const bf16_t* of = (const bf16_t*)(p->ws + WS_OGLA);
  const bf16_t* ob = of + (size_t)NTOK * 512;
  bf16_t* Y = (bf16_t*)(p->ws + WS_HY);
  const int lane = ltid() & 63;
  const int gw = bc * (NTHR / 64) + (ltid() >> 6), nw = bG * (NTHR / 64);
  const float* gain = p->in[10] + layer * 128 + (lane & 15) * 8;
  float gv[8];
#pragma unroll
  for (int e = 0; e < 8; ++e) gv[e] = gain[e];
  for (int row = gw; row < nrows; row += nw) {
    const u32x4 a = *(const u32x4*)(of + (size_t)row * 512 + lane * 8), b2 = *(const u32x4*)(ob + (size_t)row * 512 + lane * 8);
    const u32x4 g = *(const u32x4*)(proj + (size_t)row * NP + C_GR + lane * 8);
    float o[8]; float ss = 0.f;
#pragma unroll
    for (int e = 0; e < 4; ++e) { o[2 * e] = lo_bf(a[e]) + lo_bf(b2[e]); o[2 * e + 1] = hi_bf(a[e]) + hi_bf(b2[e]); }
#pragma unroll
    for (int e = 0; e < 8; ++e) ss += o[e] * o[e];
#pragma unroll
    for (int m = 8; m >= 1; m >>= 1) ss += shfl_xor_l(ss, m);
    const float rinv = rsqrtf(ss * (1.f / 128.f) + EPSF);
    u32x4 pk;
#pragma unroll
    for (int e = 0; e < 4; ++e)
      pk[e] = pk2(o[2 * e] * rinv * gv[2 * e] * siluf(lo_bf(g[e])), o[2 * e + 1] * rinv * gv[2 * e + 1] * siluf(hi_bf(g[e])));
    *(u32x4*)(Y + (size_t)row * D + lane * 8) = pk;
  }
}

__device__ __forceinline__ void phase_ffn_edge(PP p, int layer, int ntiles) {
  const float* EDGE = (const float*)(p->ws + WS_EDGE);
  bf16_t* ACT = (bf16_t*)(p->ws + WS_ACT);
  const float* cw = p->in[27] + (size_t)layer * 3 * DFF2; const float* cb = p->in[28] + (size_t)layer * DFF2;
  const long nth = (long)gridDim.x * NTHR, gt = (long)blockIdx.x * NTHR + ltid();
  const long nitems = (long)ntiles * 2 * (DFF / 4);
  for (long idx = gt; idx < nitems; idx += nth) {
    const int j = (int)(idx % (DFF / 4)) * 4; const int tb = (int)((idx / (DFF / 4)) & 1); const int tm = (int)(idx / (DFF / 2));
    const bool seq_start = tm >= 128 || (tm & 7) == 0, seq_end = tm >= 128 || (tm & 7) == 7;
    const f32x4 zz = {0.f, 0.f, 0.f, 0.f};
    f32x4 v[2][3];
#pragma unroll
    for (int bj = 0; bj < 2; ++bj) {
      const float* e0 = EDGE + ((size_t)(tm * 4) * 2 + bj) * DFF + j;
      if (tb == 0) {
        v[bj][0] = seq_start ? zz : *(const f32x4*)(e0 - (size_t)2 * DFF);
        v[bj][1] = *(const f32x4*)e0;
        v[bj][2] = *(const f32x4*)(e0 + (size_t)2 * DFF);
      } else {
        v[bj][0] = *(const f32x4*)(e0 + (size_t)4 * DFF);
        v[bj][1] = *(const f32x4*)(e0 + (size_t)6 * DFF);
        v[bj][2] = seq_end ? zz : *(const f32x4*)(e0 + (size_t)8 * DFF);
      }
    }
    float y[4];
#pragma unroll
    for (int e = 0; e < 4; ++e) {
      float cva[2];
#pragma unroll
      for (int bj = 0; bj < 2; ++bj) {
        const int jc = bj * DFF + j + e;
        cva[bj] = cb[jc] + cw[jc] * v[bj][0][e] + cw[DFF2 + jc] * v[bj][1][e] + cw[2 * DFF2 + jc] * v[bj][2][e];
      }
      y[e] = cva[0] * siluf(cva[1]);
    }
    u32x2 pk; pk[0] = pk2(y[0], y[1]); pk[1] = pk2(y[2], y[3]);
    *(u32x2*)(ACT + ((size_t)tm * 256 + (tb ? 255 : 0)) * DFF + j) = pk;
  }
}

__global__ void __launch_bounds__(NTHR) mk_fwd(Params p_unused) {
  extern __shared__ __attribute__((aligned(1024))) unsigned char shm_raw[];
  LAS unsigned char* lds = (LAS unsigned char*)shm_raw;
  cg::grid_group grid = cg::this_grid();
#ifndef REP_MASK
#define REP_MASK 0
#endif
  for (int vpc = 0; vpc < 34 * 2; ++vpc) {
    const int pc = vpc >> 1, rep = vpc & 1;
    if (rep) { if (pc < 2) { if (!((REP_MASK >> 23) & 1)) continue; } else { const int o_ = (pc - 2) % 16; const int op_ = o_ < 4 ? o_ : (o_ == 4 ? 17 : (o_ < 10 ? o_ - 1 : (o_ == 10 ? 18 : o_ - 2))); if (!((REP_MASK >> op_) & 1)) continue; } }
    PP p = (PP)__builtin_amdgcn_kernarg_segment_ptr();
    asm volatile("" : "+s"(p));
    int G = gridDim.x, c = blockIdx.x;
    asm volatile("" : "+s"(G), "+s"(c));
    const bool split = G >= 256;
    const int nglab = split ? 128 : G;
    int wG = split ? G - 128 : G;
    int wc = split ? c - 128 : c;
    unsigned char* ws = p->ws;
    bf16_t* H = (bf16_t*)(ws + WS_HY);
    float* mod = (float*)(ws + WS_MOD);
    bool sync = true;
    int gk = 0, K = 0, lda = 0, ldb = 0;
    SchedStd S; EpiBf16 E1; EpiResid E2;
    S.A = nullptr; S.B = nullptr; S.tstepA = 0; S.tstepB = 0; S.bstep_pm = 0; S.ostep_pm = 0; S.rbs = 0; S.nM = 0; S.nN = 0; S.nwg = 0; S.G = G; S.c = c; S.pm_off = 0; S.ld = 0;
    E1.O = nullptr; E1.rb_shift = 30; E1.cb_shift = 30; E1.cbs = 0; E1.rowmask = 0x7fffffff;
    E2.out = p->out; E2.cx = (float*)(ws + WS_CX); E2.gate = nullptr; E2.scale = rep ? 0.f : 1.f;
    if (pc == 0) {
      if (!(rep && ((REP_MASK >> 27) & 1))) phase_weights(p, 0, lds);
      if (!(rep && ((REP_MASK >> 28) & 1))) phase_modp(p, lds);
      if (!(rep && ((REP_MASK >> 29) & 1))) { phase_filter(p, lds); phase_fnmat(p, lds); phase_dft(p); }
    } else if (pc == 1) {
      phase_reduce(p);
    } else {
      const int layer = (pc - 2) / 16, opi = (pc - 2) % 16;
      const int op = opi < 4 ? opi : (opi == 4 ? 17 : (opi < 10 ? opi - 1 : (opi == 10 ? 18 : opi - 2)));
      const int rows_res = layer == 0 ? NTOK : NLAT;
      switch (op) {
        case 0:
          if (layer == 1) phase_weights(p, 1, lds);
          phase_norm(p, layer, 0, NTOK);
          break;
        case 1:
          S.A = (const char*)H; S.B = (const char*)(ws + WS_WTIN); S.tstepA = (size_t)256 * D * 2; S.tstepB = (size_t)256 * D * 2;
          S.nM = NTOK / 256; S.nN = NP / 256; S.ld = NP; E1.O = (bf16_t*)(ws + WS_PROJ);
          gk = 1; K = D; lda = D; ldb = D;
          break;
        case 2:
          if (c < nglab) for (int it = c; it < 128; it += nglab) gla_sweep(p, layer, it >> 3, (it >> 1) & 3, it & 1, lds, rep ? ((REP_MASK >> 24) & 7) : 0);
          sync = false;
          break;
        case 3:
          S.A = (const char*)(ws + WS_CSW) + (size_t)layer * 4 * 256 * 256 * 2; S.tstepA = (size_t)256 * 256 * 2;
          S.B = (const char*)(ws + WS_PROJ) + (size_t)C_FN * 2; S.tstepB = (size_t)256 * NP * 2; S.bstep_pm = 128 * 2;
          S.nM = 4; S.nN = NLAT / 256; S.G = wG; S.c = wc; S.ld = 4096; S.rbs = 2048; S.ostep_pm = (size_t)128 * 4096;
          E1.O = (bf16_t*)(ws + WS_UT); E1.rb_shift = 7; E1.cb_shift = 11; E1.cbs = (size_t)4 * 128 * 4096; E1.rowmask = 255;
          gk = wc >= 0 ? 1 : 0; K = 256; lda = 256; ldb = NP; sync = false;
          break;
        case 17:
          S.A = (const char*)(ws + WS_CSW) + (size_t)layer * 4 * 256 * 256 * 2; S.tstepA = (size_t)256 * 256 * 2;
          S.B = (const char*)(ws + WS_PROJ) + ((size_t)NLAT * NP + C_FN) * 2; S.tstepB = (size_t)256 * NP * 2; S.bstep_pm = 128 * 2;
          S.nM = 4; S.nN = NCTX / 256; S.G = wG; S.c = wc; S.ld = 512; S.rbs = 256; S.ostep_pm = (size_t)128 * 512;
          E1.O = (bf16_t*)(ws + WS_UTC); E1.rb_shift = 7; E1.cb_shift = 8; E1.cbs = (size_t)4 * 128 * 512; E1.rowmask = 255;
          gk = (wc >= 0 && layer == 0) ? 1 : 0; K = 256; lda = 256; ldb = NP; sync = false;
          break;
        case 4:
          if (wc >= 0) {
            for (int it = wc; it < 512 + 64; it += wG) {
              if (it < 512) item_hyprep_vt(p, layer, 0, it >> 5, it & 31, lds);
              else { const int j = it - 512; item_hyprep_vt(p, layer, 1, j >> 2, j & 3, lds); }
            }
            phase_qknorm(p, layer, wc, wG);
          }
          break;
        case 5:
          phase_gla_fin(p, layer, c, G, layer == 0 ? NTOK : NLAT);
          sync = false;
          break;
        case 6:
          wG = G; wc = c;
          S.A = (const char*)(ws + WS_DFT); S.B = (const char*)(ws + WS_UT); S.tstepA = (size_t)256 * 4096 * 2; S.tstepB = (size_t)256 * 4096 * 2;
          S.nM = 8; S.nN = 32; S.G = wG; S.c = wc; S.ld = D;
          E1.O = H + 1024; E1.cb_shift = 9; E1.cbs = (size_t)LS * D;
          gk = wc >= 0 ? 1 : 0; K = 4096; lda = 4096; ldb = 4096; sync = false;
          break;
        case 7:
          wG = G; wc = c;
          S.A = (const char*)(ws + WS_DFTC); S.B = (const char*)(ws + WS_UTC); S.tstepA = (size_t)256 * 512 * 2; S.tstepB = (size_t)256 * 512 * 2;
          S.nM = 1; S.nN = 32; S.G = wG; S.c = (wG - 1) - wc; S.ld = D;
          E1.O = H + (size_t)NLAT * D + 1024; E1.cb_shift = 9; E1.cbs = (size_t)LC * D;
          gk = (wc >= 0 && layer == 0) ? 1 : 0; K = 512; lda = 512; ldb = 512; sync = false;
          break;
        case 8:
          wG = G; wc = c;
          if (wc >= 0) {
            const int xcd = c & 7, slot = c >> 3, nslot = (G >> 3) > 0 ? (G >> 3) : 1;
            const int wid = ltid() >> 6;
            if (!(rep && ((REP_MASK >> 20) & 1))) {
              for (int cg4 = slot; cg4 < 128; cg4 += nslot) item_hyena<0>(p, layer, cg4, xcd, lds);
              if (layer == 0) for (int it = (c + G / 2) % G; it < 128; it += G) item_hyena<1>(p, layer, it, 0, lds);
            }
            if (!(rep && ((REP_MASK >> 19) & 1))) {
              LAS float* rpbl = (LAS float*)lds;
              __syncthreads();
              for (int i = ltid(); i < 15 * 31; i += NTHR) rpbl[i] = p->in[23][(size_t)(layer * 4 + (xcd & 3)) * 15 * 31 + i];
              __syncthreads();
              for (int q = slot; q < 128; q += nslot) {
                const int bh = (q >> 4) * 8 + xcd, rp = q & 15;
                item_natten(p, layer, bh >> 2, bh & 3, rp, false, lds);
              }
              if (layer == 0) for (int q = slot; q < 16; q += nslot) {
                const int bh = (q >> 1) * 8 + xcd;
                item_natten(p, layer, bh >> 2, bh & 3, q & 1, true, lds);
              }
            }
          }
          break;
        case 18:
          phase_hy_fin(p, layer, layer == 0 ? NTOK : NLAT);
          break;
        case 9:
          S.A = (const char*)H; S.B = (const char*)(ws + WS_WTOUT); S.tstepA = (size_t)256 * D * 2; S.tstepB = (size_t)256 * D * 2;
          S.nM = rows_res / 256; S.nN = D / 256; S.ld = D;
          E2.gate = mod + (size_t)layer * 17 * NMOD + 2 * D;
          gk = 2; K = D; lda = D; ldb = D;
          break;
        case 10:
          phase_norm(p, layer, 1, rows_res);
          break;
        case 11:
          S.A = (const char*)H; S.B = (const char*)(ws + WS_WTUP); S.tstepA = (size_t)256 * D * 2; S.tstepB = (size_t)256 * D * 2;
          S.nM = rows_res / 256; S.nN = DFF2 / 256; S.ld = DFF;
          gk = 3; K = D; lda = D; ldb = D;
          break;
        case 12:
          phase_ffn_edge(p, layer, rows_res / 256);
          break;
        case 13:
          S.A = (const char*)(ws + WS_ACT); S.B = (const char*)(ws + WS_WTDN); S.tstepA = (size_t)256 * DFF * 2; S.tstepB = (size_t)256 * DFF * 2;
          S.nM = rows_res / 256; S.nN = D / 256; S.ld = D;
          E2.gate = mod + (size_t)layer * 17 * NMOD + 5 * D;
          gk = 2; K = DFF; lda = DFF; ldb = DFF;
          break;
        default: break;
      }
    }
    S.nwg = S.nM * S.nN;
    if (gk == 1) gemm_phase(lds, K, lda, ldb, S, E1);
    else if (gk == 2) gemm_phase(lds, K, lda, ldb, S, E2);
    else if (gk == 3) { EpiFFN E3; E3.ACT = (bf16_t*)(ws + WS_ACT); E3.EDGE = (float*)(ws + WS_EDGE); const int layer3 = (pc - 2) / 16; E3.wcb = (const float*)(ws + WS_WCB) + (size_t)layer3 * DFF * 8; E3.halo = (LAS f32x4*)(lds + 131072); gemm_phase(lds, K, lda, ldb, S, E3); }
    if (sync || rep || ((REP_MASK >> 18) & 1)) grid.sync();
  }
}

extern "C" void kernel_launch(void* const* d_in, const int* in_sizes, int n_in, void* d_out, int out_size,
                              void* d_ws, size_t ws_size, hipStream_t stream) {
  static int grid_blocks = 0;
  if (!grid_blocks) {
    int dev = 0, cus = 0, per_cu = 0;
    (void)hipGetDevice(&dev);
    (void)hipDeviceGetAttribute(&cus, hipDeviceAttributeMultiprocessorCount, dev);
    if (hipFuncSetAttribute((const void*)mk_fwd, hipFuncAttributeMaxDynamicSharedMemorySize, LDS_BYTES) != hipSuccess)
      fprintf(stderr, "kernel_launch: hipFuncSetAttribute(%d B dynamic LDS) failed\n", LDS_BYTES);
    (void)hipOccupancyMaxActiveBlocksPerMultiprocessor(&per_cu, (const void*)mk_fwd, NTHR, LDS_BYTES);
    if (per_cu < 1) { fprintf(stderr, "kernel_launch: occupancy query returned %d\n", per_cu); per_cu = 1; }
    if (per_cu > 1) per_cu = 1;
    grid_blocks = cus * per_cu;
    if (ws_size < WS_NEED) fprintf(stderr, "kernel_launch: workspace too small: %zu < %zu\n", ws_size, (size_t)WS_NEED);
  }
  Params p{};
  for (int i = 0; i < 30; ++i) p.in[i] = (const float*)d_in[i];
  p.out = (float*)d_out; p.ws = (unsigned char*)d_ws;
  void* args[] = {&p};
  hipError_t e = hipLaunchCooperativeKernel((const void*)mk_fwd, dim3(grid_blocks), dim3(NTHR), args, LDS_BYTES, stream);
  if (e != hipSuccess) fprintf(stderr, "cooperative launch failed: %s (grid %d)\n", hipGetErrorString(e), grid_blocks);
}
```
